# Optimizing an MI355X kernel written in HIP

```python
import jax, jax.numpy as jnp
from jax import lax
import numpy as np

D_MODEL = 1024
BATCH = 16
SEQ = 2048
DEPTH = 1

D_MIX = D_MODEL
A_HEADS = 8
A_HEAD_DIM = 64
A_WIDTH = A_HEADS * A_HEAD_DIM
IDX_HEADS = 8
IDX_DIM = 32
TOPK_MAX = 256
B_HEADS = 8
B_NOPE_DIM = 64
B_ROPE_DIM = 32
B_V_DIM = 64
B_WIDTH = B_HEADS * B_V_DIM
Q_LORA = 256
KV_LORA = 128

ROPE_THETA = 10000.0
Q_BLOCK = 128
DEEPNORM_ALPHA = (2 * DEPTH) ** 0.25
DEEPNORM_BETA = (8 * DEPTH) ** -0.25
LN_EPS = 1e-5
RMS_EPS = 1e-6

IN_SPLITS = (A_WIDTH, A_WIDTH, A_WIDTH, A_WIDTH, IDX_HEADS * IDX_DIM, IDX_DIM, IDX_HEADS,
             Q_LORA, KV_LORA, B_ROPE_DIM, B_WIDTH)
D_IN = sum(IN_SPLITS)

kernel_name = "hymba_dsa_mla_deepnorm_layer"


def _split_cols(h):
    offs = np.cumsum(np.array(IN_SPLITS))[:-1].tolist()
    return jnp.split(h, offs, axis=-1)


def _rope(x, pos):
    d = x.shape[-1]
    inv = ROPE_THETA ** (-jnp.arange(0, d, 2, dtype=jnp.float32) / d)
    ang = pos.astype(jnp.float32)[..., None] * inv
    cos = jnp.cos(ang)[:, :, None, :]
    sin = jnp.sin(ang)[:, :, None, :]
    xf = x.astype(jnp.float32)
    x1, x2 = xf[..., : d // 2], xf[..., d // 2:]
    out = jnp.concatenate([x1 * cos - x2 * sin, x1 * sin + x2 * cos], axis=-1)
    return out.astype(x.dtype)


def _rmsnorm(x, g):
    xf = x.astype(jnp.float32)
    y = xf * lax.rsqrt(jnp.mean(xf * xf, axis=-1, keepdims=True) + RMS_EPS)
    return (y * g.astype(jnp.float32)).astype(x.dtype)


def _layernorm(x, g, b):
    xf = x.astype(jnp.float32)
    mu = jnp.mean(xf, axis=-1, keepdims=True)
    var = jnp.mean(jnp.square(xf - mu), axis=-1, keepdims=True)
    y = (xf - mu) * lax.rsqrt(var + LN_EPS)
    return (y * g.astype(jnp.float32) + b.astype(jnp.float32)).astype(x.dtype)


def _dsa_branch(q, k, v, iq, ik, iw):
    B, S, H, Dh = q.shape
    k_top = min(TOPK_MAX, S // 4)
    n_blocks = S // Q_BLOCK
    key_pos = jnp.arange(S)
    scale = A_HEAD_DIM ** -0.5
    idx_scale = IDX_DIM ** -0.5
    ikf = ik.astype(jnp.float32)
    iwf = iw.astype(jnp.float32) * (IDX_HEADS ** -0.5)

    def block(i):
        t0 = i * Q_BLOCK
        qb = lax.dynamic_slice_in_dim(q, t0, Q_BLOCK, axis=1).astype(jnp.float32)
        iqb = lax.dynamic_slice_in_dim(iq, t0, Q_BLOCK, axis=1).astype(jnp.float32)
        iwb = lax.dynamic_slice_in_dim(iwf, t0, Q_BLOCK, axis=1)
        qpos = t0 + jnp.arange(Q_BLOCK)
        logits = jnp.einsum('bthd,bsd->bths', iqb, ikf) * idx_scale
        score = jnp.einsum('bth,bths->bts', iwb, jax.nn.relu(logits))
        causal = key_pos[None, :] <= qpos[:, None]
        score = jnp.where(causal[None], score, -jnp.inf)
        _, sel = lax.top_k(score, k_top)
        ks = jax.vmap(lambda kb, ib: kb[ib])(k, sel).astype(jnp.float32)
        vs = jax.vmap(lambda vb, ib: vb[ib])(v, sel).astype(jnp.float32)
        att = jnp.einsum('bthd,btkhd->bhtk', qb, ks) * scale
        valid = sel <= qpos[None, :, None]
        att = jnp.where(valid[:, None], att, -jnp.inf)
        p = jax.nn.softmax(att, axis=-1)
        o = jnp.einsum('bhtk,btkhd->bthd', p, vs)
        return o.astype(q.dtype)

    out = lax.map(block, jnp.arange(n_blocks))
    return out.transpose(1, 0, 2, 3, 4).reshape(B, S, H * Dh)


def _mla_branch(c_q, c_kv, k_rope, q_norm_g, w_uq, kv_norm_g, w_ukv, pos):
    B, S, _ = c_q.shape
    q = (_rmsnorm(c_q, q_norm_g) @ w_uq).reshape(B, S, B_HEADS, B_NOPE_DIM + B_ROPE_DIM)
    q_nope, q_pe = q[..., :B_NOPE_DIM], _rope(q[..., B_NOPE_DIM:], pos)
    kv = (_rmsnorm(c_kv, kv_norm_g) @ w_ukv).reshape(B, S, B_HEADS, B_NOPE_DIM + B_V_DIM)
    k_nope = kv[..., :B_NOPE_DIM].astype(jnp.float32)
    v = kv[..., B_NOPE_DIM:].astype(jnp.float32)
    k_pe = _rope(k_rope[:, :, None, :], pos)[:, :, 0, :].astype(jnp.float32)
    scale = (B_NOPE_DIM + B_ROPE_DIM) ** -0.5
    n_blocks = S // Q_BLOCK
    key_pos = jnp.arange(S)

    def block(i):
        t0 = i * Q_BLOCK
        qn = lax.dynamic_slice_in_dim(q_nope, t0, Q_BLOCK, axis=1).astype(jnp.float32)
        qp = lax.dynamic_slice_in_dim(q_pe, t0, Q_BLOCK, axis=1).astype(jnp.float32)
        qpos = t0 + jnp.arange(Q_BLOCK)
        s = (jnp.einsum('bthd,bshd->bhts', qn, k_nope)
             + jnp.einsum('bthr,bsr->bhts', qp, k_pe)) * scale
        causal = key_pos[None, :] <= qpos[:, None]
        s = jnp.where(causal[None, None], s, -jnp.inf)
        p = jax.nn.softmax(s, axis=-1)
        o = jnp.einsum('bhts,bshd->bthd', p, v)
        return o.astype(c_q.dtype)

    out = lax.map(block, jnp.arange(n_blocks))
    return out.transpose(1, 0, 2, 3, 4).reshape(B, S, B_WIDTH)


def setup_inputs(seed: int = 0) -> dict:
    key = jax.random.key(seed)
    ks = jax.random.split(key, 10)
    x = jax.random.normal(ks[0], (BATCH, SEQ, D_MODEL), jnp.float32)
    positions = jnp.broadcast_to(jnp.arange(SEQ, dtype=jnp.int32), (BATCH, SEQ))
    col_scale = jnp.concatenate([
        jnp.ones((2 * A_WIDTH,), jnp.float32),
        jnp.full((A_WIDTH,), DEEPNORM_BETA, jnp.float32),
        jnp.ones((D_IN - 3 * A_WIDTH,), jnp.float32)])
    w_in = jax.random.normal(ks[1], (DEPTH, D_MODEL, D_IN), jnp.float32) * (D_MODEL ** -0.5) * col_scale
    q_norm_g = 1.0 + 0.01 * jax.random.normal(ks[2], (DEPTH, Q_LORA), jnp.float32)
    w_uq = jax.random.normal(ks[3], (DEPTH, Q_LORA, B_HEADS * (B_NOPE_DIM + B_ROPE_DIM)), jnp.float32) * (Q_LORA ** -0.5)
    kv_norm_g = 1.0 + 0.01 * jax.random.normal(ks[4], (DEPTH, KV_LORA), jnp.float32)
    ukv_scale = jnp.concatenate([jnp.ones((B_NOPE_DIM,), jnp.float32),
                                 jnp.full((B_V_DIM,), DEEPNORM_BETA, jnp.float32)])
    w_ukv = (jax.random.normal(ks[5], (DEPTH, KV_LORA, B_HEADS, B_NOPE_DIM + B_V_DIM), jnp.float32)
             * (KV_LORA ** -0.5) * ukv_scale).reshape(DEPTH, KV_LORA, B_HEADS * (B_NOPE_DIM + B_V_DIM))
    w_out = jax.random.normal(ks[6], (DEPTH, D_MIX, D_MODEL), jnp.float32) * (D_MIX ** -0.5) * DEEPNORM_BETA
    ln_g = 1.0 + 0.01 * jax.random.normal(ks[7], (DEPTH, D_MODEL), jnp.float32)
    ln_b = 0.01 * jax.random.normal(ks[8], (DEPTH, D_MODEL), jnp.float32)
    return {"x": x, "positions": positions, "w_in": w_in, "q_norm_g": q_norm_g,
            "w_uq": w_uq, "kv_norm_g": kv_norm_g, "w_ukv": w_ukv, "w_out": w_out,
            "ln_g": ln_g, "ln_b": ln_b}


def reference(x, positions, w_in, q_norm_g, w_uq, kv_norm_g, w_ukv, w_out, ln_g, ln_b):
    B, S, _ = x.shape
    for l in range(DEPTH):
        h = x @ w_in[l]
        (qa, ka, va, ga, iq, ik, iw, c_q, c_kv, k_rope, gb) = _split_cols(h)
        qa = _rope(qa.reshape(B, S, A_HEADS, A_HEAD_DIM), positions)
        ka = _rope(ka.reshape(B, S, A_HEADS, A_HEAD_DIM), positions)
        va = va.reshape(B, S, A_HEADS, A_HEAD_DIM)
        iq = _rope(iq.reshape(B, S, IDX_HEADS, IDX_DIM), positions)
        ik = _rope(ik[:, :, None, :], positions)[:, :, 0, :]
        o_a = _dsa_branch(qa, ka, va, iq, ik, iw) * jax.nn.silu(ga)
        o_b = _mla_branch(c_q, c_kv, k_rope, q_norm_g[l], w_uq[l], kv_norm_g[l],
                          w_ukv[l], positions) * jax.nn.silu(gb)
        out = jnp.concatenate([o_a, o_b], axis=-1) @ w_out[l]
        x = _layernorm(DEEPNORM_ALPHA * x + out, ln_g[l], ln_b[l])
    return x
```

```cpp
#include <hip/hip_runtime.h>
#include <hip/hip_cooperative_groups.h>
#include <cstdio>
#include <cstdint>
namespace cg = cooperative_groups;
#ifndef REP0
#define REP0 1
#endif
#ifndef REP1
#define REP1 1
#endif
#ifndef REP2
#define REP2 1
#endif
#ifndef REP3
#define REP3 1
#endif
#ifndef REP4
#define REP4 1
#endif
#ifndef REP5
#define REP5 1
#endif
#ifndef REP6
#define REP6 1
#endif

#define DI __device__ __forceinline__
typedef unsigned short bf16_t;
typedef short bf16x8 __attribute__((ext_vector_type(8)));
typedef short s16x4 __attribute__((ext_vector_type(4)));
typedef float f32x16 __attribute__((ext_vector_type(16)));
typedef unsigned u32x4 __attribute__((ext_vector_type(4)));
typedef unsigned u32x2 __attribute__((ext_vector_type(2)));
typedef float f32x4v __attribute__((ext_vector_type(4)));
DI float4 nt_load4(const float* p) { const f32x4v v = __builtin_nontemporal_load((const f32x4v*)p); return make_float4(v[0], v[1], v[2], v[3]); }
DI void nt_store4(float* p, float4 y) { f32x4v v = {y.x, y.y, y.z, y.w}; __builtin_nontemporal_store(v, (f32x4v*)p); }

constexpr int NB = 16, SEQ = 2048, NTOK = NB * SEQ, DM = 1024, DIN = 3272, NPAD = 3328;
constexpr float ALPHA = 1.189207115002721f;

constexpr size_t al256(size_t x) { return (x + 255) & ~(size_t)255; }
constexpr size_t OFF_WINT = 0;
constexpr size_t OFF_WUQT = OFF_WINT + al256((size_t)NPAD * 1024 * 2);
constexpr size_t OFF_WUKVT = OFF_WUQT + al256((size_t)1024 * 256 * 2);
constexpr size_t OFF_WOUTT = OFF_WUKVT + al256((size_t)1024 * 128 * 2);
constexpr size_t OFF_XB = OFF_WOUTT + al256((size_t)1024 * 1024 * 2);
constexpr size_t OFF_ROPE = OFF_XB + al256((size_t)NTOK * 1024 * 2);
constexpr size_t OFF_QA = OFF_ROPE + al256((size_t)NTOK * 32 * 8);
constexpr size_t OFF_KA = OFF_QA + al256((size_t)NTOK * 512 * 2);
constexpr size_t OFF_VTA = OFF_KA + al256((size_t)NTOK * 512 * 2);
constexpr size_t OFF_GATE = OFF_VTA + al256((size_t)NTOK * 512 * 2);
constexpr size_t OFF_IQ = OFF_GATE + al256((size_t)NTOK * 1024 * 2);
constexpr size_t OFF_IK = OFF_IQ + al256((size_t)NTOK * 256 * 2);
constexpr size_t OFF_IW = OFF_IK + al256((size_t)NTOK * 32 * 2);
constexpr size_t OFF_CQ = OFF_IW + al256((size_t)NTOK * 8 * 4);
constexpr size_t OFF_CKV = OFF_CQ + al256((size_t)NTOK * 256 * 2);
constexpr size_t OFF_KPE = OFF_CKV + al256((size_t)NTOK * 128 * 2);
constexpr size_t OFF_QB = OFF_KPE + al256((size_t)NTOK * 32 * 2);
constexpr size_t OFF_KB = OFF_QB + al256((size_t)NTOK * 768 * 2);
constexpr size_t OFF_VTB = OFF_KB + al256((size_t)NTOK * 512 * 2);
constexpr size_t OFF_MASK = OFF_VTB + al256((size_t)NTOK * 512 * 2);
constexpr size_t OFF_BAR = OFF_MASK + al256((size_t)NB * 64 * 64 * 32 * 4);
constexpr size_t WS_END = OFF_BAR + 256;

struct Params {
    const float* x; const int* pos; const float* w_in; const float* qg; const float* w_uq; const float* kvg;
    const float* w_ukv; const float* w_out; const float* ln_g; const float* ln_b; float* out; char* ws;
};

DI void lds_barrier() { __builtin_amdgcn_fence(__ATOMIC_RELEASE, "workgroup", "local"); __builtin_amdgcn_s_barrier(); __builtin_amdgcn_fence(__ATOMIC_ACQUIRE, "workgroup", "local"); }
DI void fast_grid_barrier(unsigned* ctr, unsigned target) {
    asm volatile("s_waitcnt vmcnt(0)" ::: "memory");
    __syncthreads();
    if (threadIdx.x == 0) {
        __builtin_amdgcn_fence(__ATOMIC_RELEASE, "agent");
        asm volatile("s_waitcnt vmcnt(0)" ::: "memory");
        __hip_atomic_fetch_add(ctr, 1u, __ATOMIC_RELAXED, __HIP_MEMORY_SCOPE_AGENT);
        unsigned spins = 0;
        while (__hip_atomic_load(ctr, __ATOMIC_RELAXED, __HIP_MEMORY_SCOPE_AGENT) < target && ++spins < (1u << 22)) __builtin_amdgcn_s_sleep(2);
        __builtin_amdgcn_fence(__ATOMIC_ACQUIRE, "agent");
        asm volatile("s_waitcnt vmcnt(0)" ::: "memory");
    }
    __syncthreads();
}
DI int crow(int i, int h) { return (i & 3) + 8 * (i >> 2) + 4 * h; }
typedef float f32x2v __attribute__((ext_vector_type(2)));
typedef __bf16 bf16x2v __attribute__((ext_vector_type(2)));
DI unsigned cvt_pk_bf16(float lo, float hi) { const f32x2v v = {lo, hi}; const bf16x2v b = __builtin_convertvector(v, bf16x2v); return __builtin_bit_cast(unsigned, b); }
DI bf16_t f2bf(float x) { return (bf16_t)(cvt_pk_bf16(x, 0.f) & 0xffffu); }
DI float bf2f(unsigned short v) { return __uint_as_float(((unsigned)v) << 16); }
DI float silu(float x) { return x * __builtin_amdgcn_rcpf(1.f + __builtin_amdgcn_exp2f(-1.44269504089f * x)); }
DI float xor32_max(float x) { auto t = __builtin_amdgcn_permlane32_swap(__float_as_uint(x), __float_as_uint(x), false, false); return fmaxf(__uint_as_float(t[0]), __uint_as_float(t[1])); }
DI float xor32_sum(float x) { auto t = __builtin_amdgcn_permlane32_swap(__float_as_uint(x), __float_as_uint(x), false, false); return __uint_as_float(t[0]) + __uint_as_float(t[1]); }
DI int xrow16_sum_i(int x) {
    auto s = __builtin_amdgcn_permlane16_swap((unsigned)x, (unsigned)x, false, false);
    x = (int)(s[0] + s[1]);
    auto t = __builtin_amdgcn_permlane32_swap((unsigned)x, (unsigned)x, false, false);
    return (int)(t[0] + t[1]);
}
DI unsigned xrow16_or(unsigned x) {
    auto s = __builtin_amdgcn_permlane16_swap(x, x, false, false);
    x = s[0] | s[1];
    auto t = __builtin_amdgcn_permlane32_swap(x, x, false, false);
    return t[0] | t[1];
}
template <int CTRL> DI int dpp_i(int x) { return __builtin_amdgcn_mov_dpp(x, CTRL, 0xf, 0xf, true); }
DI int wave_sum_i(int x) {
    x += dpp_i<0xB1>(x);
    x += dpp_i<0x4E>(x);
    x += dpp_i<0x141>(x);
    x += dpp_i<0x140>(x);
    return xrow16_sum_i(x);
}
#define CNT4(c0, c1, c2, c3, k0, k1, k2, k3, cand) do { unsigned long long t0_, t1_, t2_, t3_; \
    asm("v_cmp_le_u32_e64 %4, %12, %8\n\tv_cmp_le_u32_e64 %5, %12, %9\n\tv_cmp_le_u32_e64 %6, %12, %10\n\tv_cmp_le_u32_e64 %7, %12, %11\n\t" \
        "v_addc_co_u32_e64 %0, %4, %0, 0, %4\n\tv_addc_co_u32_e64 %1, %5, %1, 0, %5\n\tv_addc_co_u32_e64 %2, %6, %2, 0, %6\n\tv_addc_co_u32_e64 %3, %7, %3, 0, %7" \
        : "+v"(c0), "+v"(c1), "+v"(c2), "+v"(c3), "=&s"(t0_), "=&s"(t1_), "=&s"(t2_), "=&s"(t3_) \
        : "v"(k0), "v"(k1), "v"(k2), "v"(k3), "s"(cand)); } while (0)
#define MFMA32(a, b, c) __builtin_amdgcn_mfma_f32_32x32x16_bf16((a), (b), (c), 0, 0, 0)

struct MapIn { DI int operator()(int p) const {
    if (p < 2048) return p;
    if (p < 2304) { int q = p - 2048, gq = q >> 6, c = q & 63, half = c >> 5, hh = (c & 31) >> 4, i = c & 15; return 2048 + (2 * gq + hh) * 32 + half * 16 + i; }
    if (p < 2368) { int c = p - 2304, half = c >> 5, sub = (c & 31) >> 4, i = c & 15; return (sub ? 2728 : 2304) + half * 16 + i; }
    if (p < 2432) { int c = p - 2368; return c < 8 ? 2336 + c : -1; }
    if (p < 2688) return 2344 + (p - 2432);
    if (p < 2816) return 2600 + (p - 2688);
    return 2760 + (p - 2816);
} };
struct MapUq { DI int operator()(int p) const {
    int head = p >> 7, c = p & 127;
    if (c < 64) return head * 96 + c;
    int c2 = c - 64, half = c2 >> 5, i = c2 & 31;
    return i < 16 ? head * 96 + 64 + half * 16 + i : -1;
} };
struct MapId { DI int operator()(int p) const { return p; } };

template <class Map>
DI void transpose_convert(const float* __restrict__ src, int ldsrc, int K, int P, bf16_t* __restrict__ dst, const float* __restrict__ kscale, Map map, float* tile) {
    const int tid = threadIdx.x;
    const int tilesK = K >> 6, tilesP = P >> 6;
    for (int t = blockIdx.x; t < tilesK * tilesP; t += gridDim.x) {
        const int tk = t % tilesK, tp = t / tilesK;
        const int c = tid & 63, r0 = tid >> 6;
        const int oc = map(tp * 64 + c);
        __syncthreads();
#pragma unroll
        for (int i = 0; i < 8; ++i) {
            const int r = r0 + 8 * i, k = tk * 64 + r;
            float v = oc >= 0 ? src[(size_t)k * ldsrc + oc] : 0.f;
            if (kscale) v *= kscale[k];
            tile[r * 65 + c] = v;
        }
        __syncthreads();
        const int prow = tid >> 3, kseg = (tid & 7) * 8;
        u32x4 o;
#pragma unroll
        for (int j = 0; j < 4; ++j) o[j] = cvt_pk_bf16(tile[(kseg + 2 * j) * 65 + prow], tile[(kseg + 2 * j + 1) * 65 + prow]);
        *(u32x4*)(dst + (size_t)(tp * 64 + prow) * K + tk * 64 + kseg) = o;
    }
}

constexpr int G_STAGE = 49152;
constexpr int LDS_BYTES = 3 * G_STAGE + 2048;
#define RAW_BARRIER() do { asm volatile("s_waitcnt lgkmcnt(0)" ::: "memory"); __builtin_amdgcn_s_barrier(); } while (0)
DI void glds16(const bf16_t* g, char* l) { __builtin_amdgcn_global_load_lds((const unsigned*)g, (unsigned*)l, 16, 0, 0); }
template <class Epi>
DI void gemm256(const bf16_t* __restrict__ A, int lda, const bf16_t* __restrict__ Bt, int ldb, int K, int m0, int n0, char* lds, Epi epi) {
    const int tid = threadIdx.x, lane = tid & 63, w = __builtin_amdgcn_readfirstlane(tid >> 6), wm = w >> 1, wn = w & 1, r = lane & 31, h = lane >> 5;
    const int lr = lane >> 3, lp = lane & 7;
    auto issue = [&](int kt, int st) {
        char* sb = lds + st * G_STAGE;
#pragma unroll
        for (int i = 0; i < 4; ++i) {
            const int rowb = (w * 4 + i) * 8, row = rowb + lr, c = lp ^ ((row >> 1) & 7);
            glds16(A + (size_t)(m0 + row) * lda + kt * 64 + c * 8, sb + rowb * 128);
        }
#pragma unroll
        for (int i = 0; i < 2; ++i) {
            const int rowb = (w * 2 + i) * 8, row = rowb + lr, c = lp ^ ((row >> 1) & 7);
            glds16(Bt + (size_t)(n0 + row) * ldb + kt * 64 + c * 8, sb + 32768 + rowb * 128);
        }
    };
    f32x16 acc[2][2];
#pragma unroll
    for (int a = 0; a < 2; ++a)
#pragma unroll
        for (int b = 0; b < 2; ++b)
#pragma unroll
            for (int i = 0; i < 16; ++i) acc[a][b][i] = 0.f;
    const int nk = K >> 6;
    epi.prefetch(m0 + 64 * wm, wn, r, h);
    RAW_BARRIER();
    issue(0, 0);
    if (nk > 1) issue(1, 1);
#pragma unroll 1
    for (int kt = 0; kt < nk; ++kt) {
        if (kt + 1 < nk) asm volatile("s_waitcnt vmcnt(6)" ::: "memory"); else asm volatile("s_waitcnt vmcnt(0)" ::: "memory");
        RAW_BARRIER();
        if (kt + 2 < nk) issue(kt + 2, (kt + 2) % 3);
        const char* sa = lds + (kt % 3) * G_STAGE;
        const char* sbb = sa + 32768;
#pragma unroll
        for (int ks = 0; ks < 4; ++ks) {
            bf16x8 af[2], bfr[2];
#pragma unroll
            for (int mi = 0; mi < 2; ++mi) { const int row = 64 * wm + 32 * mi + r; af[mi] = *(const bf16x8*)(sa + row * 128 + (((2 * ks + h) ^ ((row >> 1) & 7)) << 4)); }
#pragma unroll
            for (int j = 0; j < 2; ++j) { const int row = 64 * wn + 32 * j + r; bfr[j] = *(const bf16x8*)(sbb + row * 128 + (((2 * ks + h) ^ ((row >> 1) & 7)) << 4)); }
#pragma unroll
            for (int mi = 0; mi < 2; ++mi)
#pragma unroll
                for (int j = 0; j < 2; ++j) acc[mi][j] = MFMA32(af[mi], bfr[j], acc[mi][j]);
        }
    }
    epi(acc[0][0], acc[0][1], m0 + 64 * wm, wn, r, h, 0);
    epi(acc[1][0], acc[1][1], m0 + 64 * wm + 32, wn, r, h, 1);
}

constexpr int G2_STAGE = 32768;
template <class Epi>
DI void gemm256x256(const bf16_t* __restrict__ A, int lda, const bf16_t* __restrict__ Bt, int ldb, int K, int m0, int n0, char* lds, Epi epi) {
    const int tid = threadIdx.x, lane = tid & 63, w = __builtin_amdgcn_readfirstlane(tid >> 6), wm = w >> 1, wn = w & 1, r = lane & 31, h = lane >> 5;
    const int lr = lane >> 2, lp = lane & 3;
    auto issue = [&](int kt, int st) {
        char* sb = lds + st * G2_STAGE;
#pragma unroll
        for (int i = 0; i < 2; ++i) {
            const int rowb = (w * 2 + i) * 16, row = rowb + lr, c = lp ^ ((row >> 2) & 3);
            glds16(A + (size_t)(m0 + row) * lda + kt * 32 + c * 8, sb + rowb * 64);
            glds16(Bt + (size_t)(n0 + row) * ldb + kt * 32 + c * 8, sb + 16384 + rowb * 64);
        }
    };
    f32x16 acc[2][4];
#pragma unroll
    for (int a = 0; a < 2; ++a)
#pragma unroll
        for (int b = 0; b < 4; ++b)
#pragma unroll
            for (int i = 0; i < 16; ++i) acc[a][b][i] = 0.f;
    const int nk = K >> 5;
    const int grp0 = (n0 >> 6) + 2 * wn;
    epi.prefetch_mi(m0 + 64 * wm, grp0, r, h, 0);
    RAW_BARRIER();
    issue(0, 0); issue(1, 1); issue(2, 2);
#pragma unroll 2
    for (int kt = 0; kt < nk; ++kt) {
        if (kt + 2 < nk) asm volatile("s_waitcnt vmcnt(8)" ::: "memory");
        else if (kt + 1 < nk) asm volatile("s_waitcnt vmcnt(4)" ::: "memory");
        else asm volatile("s_waitcnt vmcnt(0)" ::: "memory");
        RAW_BARRIER();
        if (kt + 3 < nk) issue(kt + 3, (kt + 3) & 3);
        const char* sa = lds + (kt & 3) * G2_STAGE;
        const char* sbb = sa + 16384;
#pragma unroll
        for (int ks = 0; ks < 2; ++ks) {
            bf16x8 af[2], bfr[4];
#pragma unroll
            for (int mi = 0; mi < 2; ++mi) { const int row = 64 * wm + 32 * mi + r; af[mi] = *(const bf16x8*)(sa + row * 64 + (((2 * ks + h) ^ ((row >> 2) & 3)) << 4)); }
#pragma unroll
            for (int j = 0; j < 4; ++j) { const int row = 128 * wn + 32 * j + r; bfr[j] = *(const bf16x8*)(sbb + row * 64 + (((2 * ks + h) ^ ((row >> 2) & 3)) << 4)); }
#pragma unroll
            for (int mi = 0; mi < 2; ++mi)
#pragma unroll
                for (int j = 0; j < 4; ++j) acc[mi][j] = MFMA32(af[mi], bfr[j], acc[mi][j]);
        }
    }
    epi(acc[0][0], acc[0][1], m0 + 64 * wm, grp0, r, h, 0);
    epi.prefetch_mi(m0 + 64 * wm, grp0, r, h, 1);
    epi(acc[0][2], acc[0][3], m0 + 64 * wm, grp0 + 1, r, h, 0);
    epi(acc[1][0], acc[1][1], m0 + 64 * wm + 32, grp0, r, h, 1);
    epi(acc[1][2], acc[1][3], m0 + 64 * wm + 32, grp0 + 1, r, h, 1);
}

DI void store_vt4(bf16_t* vt, int head, int d, int row, float a, float b, float c, float e) {
    const int bb = row >> 11, s0_ = row & 2047, s = (s0_ & ~12) | ((s0_ & 4) << 1) | ((s0_ & 8) >> 1);
    u32x2 v; v[0] = cvt_pk_bf16(a, b); v[1] = cvt_pk_bf16(c, e);
    *(u32x2*)(vt + (unsigned)(((bb * 8 + head) * 64 + d) * 2048 + s)) = v;
}

struct EpiIn {
    char* ws; int nt; float2 pcs[2][16];
    DI void prefetch_mi(int row0, int wn, int r, int h, int mi) {
        const int grp = nt * 2 + wn;
        const float2* rope = (const float2*)(ws + OFF_ROPE);
        if (grp < 16 || (grp >= 32 && grp < 37)) {
            const int idx = grp < 16 ? r : 2 * (r & 15);
#pragma unroll
            for (int i = 0; i < 16; ++i) {
                const float2 v = rope[(unsigned)(row0 + 32 * mi + crow(i, h)) * 32u + idx];
                if (mi) pcs[1][i] = v; else pcs[0][i] = v;
            }
        }
    }
    DI void prefetch(int row0, int wn, int r, int h) { prefetch_mi(row0, wn, r, h, 0); prefetch_mi(row0, wn, r, h, 1); }
    DI void operator()(const f32x16& a0, const f32x16& a1, int row0, int wn, int r, int h, int mi) {
        const int grp = nt * 2 + wn;
        if (grp < 16) {
            bf16_t* dst = (bf16_t*)(ws + (grp < 8 ? OFF_QA : OFF_KA));
            const int head = grp & 7;
#pragma unroll
            for (int i = 0; i < 16; ++i) {
                const int row = row0 + crow(i, h);
                const float2 cs = mi ? pcs[1][i] : pcs[0][i];
                const float x1 = a0[i], x2 = a1[i];
                dst[(unsigned)row * 512u + head * 64 + r] = f2bf(x1 * cs.x - x2 * cs.y);
                dst[(unsigned)row * 512u + head * 64 + 32 + r] = f2bf(x1 * cs.y + x2 * cs.x);
            }
        } else if (grp < 24) {
            bf16_t* vt = (bf16_t*)(ws + OFF_VTA);
            const int head = grp - 16;
#pragma unroll
            for (int g = 0; g < 4; ++g) {
                const int row = row0 + 8 * g + 4 * h;
                store_vt4(vt, head, r, row, a0[4 * g], a0[4 * g + 1], a0[4 * g + 2], a0[4 * g + 3]);
                store_vt4(vt, head, 32 + r, row, a1[4 * g], a1[4 * g + 1], a1[4 * g + 2], a1[4 * g + 3]);
            }
        } else if (grp < 32 || grp >= 44) {
            bf16_t* gate = (bf16_t*)(ws + OFF_GATE);
            const int cb = grp < 32 ? (grp - 24) * 64 : 512 + (grp - 44) * 64;
#pragma unroll
            for (int i = 0; i < 16; ++i) {
                const int row = row0 + crow(i, h);
                gate[(unsigned)row * 1024u + cb + r] = f2bf(silu(a0[i]));
                gate[(unsigned)row * 1024u + cb + 32 + r] = f2bf(silu(a1[i]));
            }
        } else if (grp < 37) {
            const int hh = r >> 4, i16 = r & 15;
            bf16_t* dst; int ld, cb;
            if (grp < 36) { dst = (bf16_t*)(ws + OFF_IQ); ld = 256; cb = (2 * (grp - 32) + hh) * 32; }
            else { dst = (bf16_t*)(ws + (hh ? OFF_KPE : OFF_IK)); ld = 32; cb = 0; }
#pragma unroll
            for (int i = 0; i < 16; ++i) {
                const int row = row0 + crow(i, h);
                const float2 cs = mi ? pcs[1][i] : pcs[0][i];
                const float x1 = a0[i], x2 = a1[i];
                dst[(unsigned)row * (unsigned)ld + cb + i16] = f2bf(x1 * cs.x - x2 * cs.y);
                dst[(unsigned)row * (unsigned)ld + cb + 16 + i16] = f2bf(x1 * cs.y + x2 * cs.x);
            }
        } else if (grp == 37) {
            float* iw = (float*)(ws + OFF_IW);
            if (r < 8) {
#pragma unroll
                for (int i = 0; i < 16; ++i) iw[(unsigned)(row0 + crow(i, h)) * 8u + r] = a0[i] * 0.0625f;
            }
        } else {
            bf16_t* dst; int ld, cb;
            if (grp < 42) { dst = (bf16_t*)(ws + OFF_CQ); ld = 256; cb = (grp - 38) * 64; }
            else { dst = (bf16_t*)(ws + OFF_CKV); ld = 128; cb = (grp - 42) * 64; }
#pragma unroll
            for (int i = 0; i < 16; ++i) {
                const int row = row0 + crow(i, h);
                dst[(unsigned)row * (unsigned)ld + cb + r] = f2bf(a0[i]);
                dst[(unsigned)row * (unsigned)ld + cb + 32 + r] = f2bf(a1[i]);
            }
        }
    }
};

struct EpiUq {
    char* ws; int head; const float* rs; int m0;
    DI void prefetch(int, int, int, int) {}
    DI void operator()(const f32x16& a0, const f32x16& a1, int row0, int wn, int r, int h, int) const {
        bf16_t* qb = (bf16_t*)(ws + OFF_QB);
        const float2* rope = (const float2*)(ws + OFF_ROPE);
        if (wn == 0) {
#pragma unroll
            for (int i = 0; i < 16; ++i) {
                const int row = row0 + crow(i, h); const float s = rs[row - m0];
                qb[(size_t)row * 768 + head * 96 + r] = f2bf(a0[i] * s);
                qb[(size_t)row * 768 + head * 96 + 32 + r] = f2bf(a1[i] * s);
            }
        } else if (r < 16) {
#pragma unroll
            for (int i = 0; i < 16; ++i) {
                const int row = row0 + crow(i, h); const float s = rs[row - m0];
                const float2 cs = rope[(size_t)row * 32 + 2 * r];
                const float x1 = a0[i] * s, x2 = a1[i] * s;
                qb[(size_t)row * 768 + head * 96 + 64 + r] = f2bf(x1 * cs.x - x2 * cs.y);
                qb[(size_t)row * 768 + head * 96 + 80 + r] = f2bf(x1 * cs.y + x2 * cs.x);
            }
        }
    }
};
struct EpiUkv {
    char* ws; int head; const float* rs; int m0;
    DI void prefetch(int, int, int, int) {}
    DI void operator()(const f32x16& a0, const f32x16& a1, int row0, int wn, int r, int h, int) const {
        if (wn == 0) {
            bf16_t* kb = (bf16_t*)(ws + OFF_KB);
#pragma unroll
            for (int i = 0; i < 16; ++i) {
                const int row = row0 + crow(i, h); const float s = rs[row - m0];
                kb[(size_t)row * 512 + head * 64 + r] = f2bf(a0[i] * s);
                kb[(size_t)row * 512 + head * 64 + 32 + r] = f2bf(a1[i] * s);
            }
        } else {
            bf16_t* vt = (bf16_t*)(ws + OFF_VTB);
#pragma unroll
            for (int g = 0; g < 4; ++g) {
                const int row = row0 + 8 * g + 4 * h;
                const float s0 = rs[row - m0], s1 = rs[row - m0 + 1], s2 = rs[row - m0 + 2], s3 = rs[row - m0 + 3];
                store_vt4(vt, head, r, row, a0[4 * g] * s0, a0[4 * g + 1] * s1, a0[4 * g + 2] * s2, a0[4 * g + 3] * s3);
                store_vt4(vt, head, 32 + r, row, a1[4 * g] * s0, a1[4 * g + 1] * s1, a1[4 * g + 2] * s2, a1[4 * g + 3] * s3);
            }
        }
    }
};
DI void row_rms(const bf16_t* A, int K, int m0, float* rs) {
    const int tid = threadIdx.x, row = tid >> 1, part = tid & 1, n = K >> 1;
    const bf16_t* p = A + (size_t)(m0 + row) * K + part * n;
    float s = 0.f;
    for (int j = 0; j < n; j += 8) {
        const u32x4 v = *(const u32x4*)(p + j);
#pragma unroll
        for (int q = 0; q < 4; ++q) { const float lo = __uint_as_float(v[q] << 16), hi = __uint_as_float(v[q] & 0xffff0000u); s += lo * lo + hi * hi; }
    }
    s += __shfl_xor(s, 1);
    __syncthreads();
    if (part == 0) rs[row] = __builtin_amdgcn_rsqf(s / (float)K + 1e-6f);
}

struct EpiOut {
    const float* x; float* out; int n0; float xv[2][2][16];
    DI void prefetch(int row0, int wn, int r, int h) {
#pragma unroll
        for (int mi = 0; mi < 2; ++mi)
#pragma unroll
            for (int i = 0; i < 16; ++i) {
                const size_t o = (size_t)(row0 + 32 * mi + crow(i, h)) * 1024 + n0 + 64 * wn + r;
                xv[mi][0][i] = x[o]; xv[mi][1][i] = x[o + 32];
            }
    }
    DI void operator()(const f32x16& a0, const f32x16& a1, int row0, int wn, int r, int h, int mi) {
#pragma unroll
        for (int i = 0; i < 16; ++i) {
            const size_t o = (size_t)(row0 + crow(i, h)) * 1024 + n0 + 64 * wn + r;
            out[o] = ALPHA * (mi ? xv[1][0][i] : xv[0][0][i]) + a0[i];
            out[o + 32] = ALPHA * (mi ? xv[1][1][i] : xv[0][1][i]) + a1[i];
        }
    }
};

typedef float f32x4 __attribute__((ext_vector_type(4)));
#define MFMA16(a, b, c) __builtin_amdgcn_mfma_f32_16x16x32_bf16((a), (b), (c), 0, 0, 0)
DI void indexer_stream(char* ws, char* lds, int G, int bid, int nrep) {
    constexpr int KMS = 2052;
    bf16_t* iqs = (bf16_t*)lds;
    unsigned* KM = (unsigned*)(lds + 16 * 264 * 2);
    const int tid = threadIdx.x, lane = tid & 63, w = __builtin_amdgcn_readfirstlane(tid >> 6), q = lane & 15, g = lane >> 4;
    const bf16_t* iq = (const bf16_t*)(ws + OFF_IQ);
    const bf16_t* ik = (const bf16_t*)(ws + OFF_IK);
    const float* iw = (const float*)(ws + OFF_IW);
    unsigned* maskw = (unsigned*)(ws + OFF_MASK);
    const int nrounds = (2048 + G - 1) / G, total = nrounds * nrep;
    auto unit_of = [&](int it, int& ub, int& uq) -> bool {
        if (it >= total) return false;
        const int rd = it % nrounds;
        const int u = (rd & 1) ? rd * G + (G - 1 - bid) : rd * G + bid;
        if (u >= 2048) return false;
        ub = u & 15; uq = 127 - (u >> 4);
        return true;
    };
    u32x4 iqrow; float wv[8]; bf16x8 af[16];
    auto load_inputs = [&](int ub, int uq) {
        const int tk0 = ub * SEQ + uq * 16;
        iqrow = *(const u32x4*)(iq + (size_t)(tk0 + (tid >> 5)) * 256 + (tid & 31) * 8);
        const float4 w0 = *(const float4*)(iw + (size_t)(tk0 + q) * 8), w1 = *(const float4*)(iw + (size_t)(tk0 + q) * 8 + 4);
        wv[0] = w0.x; wv[1] = w0.y; wv[2] = w0.z; wv[3] = w0.w; wv[4] = w1.x; wv[5] = w1.y; wv[6] = w1.z; wv[7] = w1.w;
#pragma unroll
        for (int jj = 0; jj < 16; ++jj) {
            const int kt = 2 * (w + 8 * (jj >> 1)) + (jj & 1);
            if (kt < uq + 1) af[jj] = *(const bf16x8*)(ik + (size_t)(ub * SEQ + kt * 16 + q) * 32 + 8 * g);
        }
    };
    int b = 0, qb16 = 0;
    bool have = unit_of(0, b, qb16);
    if (have) load_inputs(b, qb16);
  for (int it = 0; have; ++it) {
    const int ntiles = qb16 + 1;
    lds_barrier();
    *(u32x4*)(iqs + (tid >> 5) * 264 + (tid & 31) * 8) = iqrow;
    lds_barrier();
    bf16x8 bqr[8];
#pragma unroll
    for (int hd = 0; hd < 8; ++hd) bqr[hd] = *(const bf16x8*)(iqs + q * 264 + hd * 32 + 8 * g);
#pragma unroll
    for (int jj = 0; jj < 16; ++jj) {
        const int kt = 2 * (w + 8 * (jj >> 1)) + (jj & 1);
        if (kt < ntiles) {
            const int s0 = kt * 16;
            const int vlim = qb16 * 16 + q - s0 - 4 * g;
            const bf16x8 a = af[jj];
            f32x4 sc = {0.f, 0.f, 0.f, 0.f};
#pragma unroll
            for (int hd = 0; hd < 8; ++hd) {
                const bf16x8 bq = bqr[hd];
                f32x4 t = {0.f, 0.f, 0.f, 0.f};
                t = MFMA16(a, bq, t);
#pragma unroll
                for (int i = 0; i < 4; ++i) sc[i] = fmaf(wv[hd], fmaxf(t[i], 0.f), sc[i]);
            }
            u32x4 kv;
#pragma unroll
            for (int i = 0; i < 4; ++i) {
                const float xx = sc[i] + 0.0f;
                const unsigned u = __float_as_uint(xx);
                const unsigned k = u ^ ((unsigned)((int)u >> 31) | 0x80000000u);
                kv[i] = (i <= vlim) ? k : 0u;
            }
            *(u32x4*)(KM + q * KMS + s0 + 4 * g) = kv;
        }
    }
    int nb = 0, nq = 0;
    const bool hn = unit_of(it + 1, nb, nq);
    if (hn) load_inputs(nb, nq);
    lds_barrier();
    const int nk = ntiles * 16;
    unsigned KA[32], KB[32];
#pragma unroll
    for (int i = 0; i < 32; ++i) {
        const int idx = 64 * i + lane;
        KA[i] = 0u; KB[i] = 0u;
        if (64 * i < nk) {
            const bool in = idx < nk;
            const unsigned va = KM[(2 * w) * KMS + (in ? idx : 0)], vb = KM[(2 * w + 1) * KMS + (in ? idx : 0)];
            KA[i] = in ? va : 0u; KB[i] = in ? vb : 0u;
        }
    }
    unsigned TA = 0, TB = 0; int cgeA = 2048, cgeB = 2048;
    const int nvalA = qb16 * 16 + 2 * w + 1, nvalB = nvalA + 1;
    bool doneA = nvalA <= 256, doneB = nvalB <= 256;
    for (int bit = 31; bit >= 0; --bit) {
        if (doneA && doneB) break;
        const unsigned candA = TA | (1u << bit), candB = TB | (1u << bit);
        int a0 = 0, a1 = 0, a2 = 0, a3 = 0, b0 = 0, b1 = 0, b2 = 0, b3 = 0;
#pragma unroll
        for (int gq = 0; gq < 4; ++gq) {
            if (512 * gq < nk) {
#pragma unroll
                for (int i = 8 * gq; i < 8 * gq + 8; i += 4) {
                    CNT4(a0, a1, a2, a3, KA[i], KA[i + 1], KA[i + 2], KA[i + 3], candA);
                    CNT4(b0, b1, b2, b3, KB[i], KB[i + 1], KB[i + 2], KB[i + 3], candB);
                }
            }
        }
        const int cA = __builtin_amdgcn_readfirstlane(wave_sum_i((a0 + a1) + (a2 + a3)));
        const int cB = __builtin_amdgcn_readfirstlane(wave_sum_i((b0 + b1) + (b2 + b3)));
        if (!doneA && cA >= 256) { TA = candA; cgeA = cA; doneA = (cA == 256); }
        if (!doneB && cB >= 256) { TB = candB; cgeB = cB; doneB = (cB == 256); }
    }
    const int qb32 = qb16 >> 1;
#pragma unroll
    for (int qq = 0; qq < 2; ++qq) {
        const unsigned T = qq ? TB : TA;
        const int cge = qq ? cgeB : cgeA;
        const bool tie = (T != 0u) && (cge > 256);
        int need = 1 << 30;
        if (tie) {
            int cgt = 0;
#pragma unroll
            for (int i = 0; i < 32; ++i) cgt += __builtin_popcountll(__builtin_amdgcn_ballot_w64((qq ? KB[i] : KA[i]) > T));
            need = 256 - cgt;
        }
        unsigned long long* wscr = (unsigned long long*)(lds + 16 * 264 * 2 + 16 * KMS * 4) + (w * 2 + qq) * 32;
        if (!tie) {
            const unsigned Tm = T > 1u ? T : 1u;
#pragma unroll
            for (int i = 0; i < 32; ++i) {
                const unsigned long long sel = __builtin_amdgcn_ballot_w64((qq ? KB[i] : KA[i]) >= Tm);
                if (lane == 0) wscr[i] = sel;
            }
        } else
#pragma unroll
        for (int i = 0; i < 32; ++i) {
            const unsigned k = qq ? KB[i] : KA[i];
            const unsigned long long gt = __builtin_amdgcn_ballot_w64(k > T);
            unsigned long long eq = __builtin_amdgcn_ballot_w64(k == T && k != 0u);
            if (tie) {
                if (need <= 0) eq = 0ull;
                else {
                    const int ce = __builtin_popcountll(eq);
                    if (ce > need) {
                        unsigned long long mm = eq, keep = 0ull;
                        for (int n = need; n > 0; --n) { const unsigned long long lb = mm & (0ull - mm); keep |= lb; mm ^= lb; }
                        eq = keep;
                    }
                    need -= __builtin_popcountll(eq);
                }
            }
            const unsigned long long sel = gt | eq;
            if (lane == 0) wscr[i] = sel;
        }
        const unsigned myword = ((const unsigned*)wscr)[lane];
        const int r32 = (qb16 & 1) * 16 + 2 * w + qq;
        if (lane <= qb32) maskw[((size_t)(b * 64 + qb32) * 64 + lane) * 32 + r32] = myword;
    }
    b = nb; qb16 = nq; have = hn;
  }
}

constexpr int A_STAGE = 20480;
DI void glds4(const unsigned* g, char* l) { __builtin_amdgcn_global_load_lds(g, (unsigned*)l, 4, 0, 0); }
struct AUnit { const bf16_t* q; const bf16_t* k; const bf16_t* kpe; const bf16_t* vt; const unsigned* mwb; const bf16_t* gate; bf16_t* out; int c; };
constexpr int AQ_OFF = 4 * A_STAGE;
template <int DQK, bool MASKED>
DI void attn_block(const AUnit& U, int ldq, float cscale, char* lds, bool pre, bool has_next, const AUnit& N) {
    constexpr int NKS = DQK / 16, CH = DQK / 8, QW = 32 * DQK * 2, QP = QW / 1024;
    const int tid = threadIdx.x, lane = tid & 63, w = __builtin_amdgcn_readfirstlane(tid >> 6), r = lane & 31, h = lane >> 5;
    const int c = U.c, qb32 = 8 * c + w, t0 = qb32 * 32, ntile = 4 * c + 4;
    const bf16_t* gate = U.gate; bf16_t* outp = U.out;
    const int lr8 = lane >> 3, lp8 = lane & 7, row8 = 8 * w + lr8, c8 = lp8 ^ ((row8 >> 1) & 7);
    const int row4 = 16 * (w & 3) + (lane >> 2), c4 = (lane & 3) ^ ((row4 >> 2) & 3);
    auto issue_u = [&](const AUnit& X, int j, int st) {
        char* sb = lds + st * A_STAGE;
        glds16(X.k + (size_t)row8 * 512 + c8 * 8 + (size_t)j * 64 * 512, sb + w * 1024);
        glds16(X.vt + (size_t)row8 * 2048 + c8 * 8 + j * 64, sb + 8192 + w * 1024);
        if (DQK == 96) glds16(X.kpe + (size_t)row4 * 32 + c4 * 8 + (size_t)j * 64 * 32, sb + 16384 + (w & 3) * 1024);
        if (MASKED) glds4(X.mwb + (size_t)(8 * X.c + w) * 64 * 32 + lane + j * 64, sb + 16384 + w * 256);
    };
    auto issue = [&](int j, int st) { issue_u(U, j, st); };
    auto issue_q = [&](const AUnit& X) {
        const int tx0 = (8 * X.c + w) * 32;
#pragma unroll
        for (int pz = 0; pz < QP; ++pz) {
            const int ci = pz * 64 + lane, row = ci / CH, cc = ci % CH;
            glds16(X.q + (size_t)(tx0 + row) * ldq + cc * 8, lds + AQ_OFF + w * QW + pz * 1024);
        }
    };
    bf16x8 qf[NKS];
    u32x2 gpre[2][4];
    f32x16 o0, o1;
#pragma unroll
    for (int i = 0; i < 16; ++i) { o0[i] = 0.f; o1[i] = 0.f; }
    float m = -30000.0f, l = 0.f;
    f32x16 o2;
#pragma unroll
    for (int i = 0; i < 16; ++i) o2[i] = 0.f;
    const bf16x8 ones = {16256, 16256, 16256, 16256, 16256, 16256, 16256, 16256};
    const int dlc = r - 4 * h;
    const unsigned cmask = dlc < 0 ? 0u : (dlc >= 31 ? 0xffffffffu : ((2u << dlc) - 1u));
    if (!pre) { RAW_BARRIER(); issue_q(U); issue(0, 0); issue(1, 1); }
    for (int jp = 0; jp < ntile; jp += 2) {
        asm volatile("s_waitcnt vmcnt(0)" ::: "memory");
        RAW_BARRIER();
        if (jp + 2 < ntile) { issue(jp + 2, (jp + 2) & 3); issue(jp + 3, (jp + 3) & 3); }
        else if (has_next) { issue_u(N, 0, 0); issue_u(N, 1, 1); issue_q(N); }
        if (jp == 0) {
#pragma unroll
            for (int ks = 0; ks < NKS; ++ks) qf[ks] = *(const bf16x8*)(lds + AQ_OFF + w * QW + ((r * CH + 2 * ks + h) << 4));
            const bf16_t* gp = gate + (size_t)(t0 + r) * 1024;
#pragma unroll
            for (int db = 0; db < 2; ++db)
#pragma unroll
                for (int g = 0; g < 4; ++g) gpre[db][g] = *(const u32x2*)(gp + 32 * db + 8 * g + 4 * h);
        }
#pragma unroll 1
      for (int j = jp; j < jp + 2; ++j) {
        const char* sb = lds + (j & 3) * A_STAGE;
        if (2 * j <= qb32) {
            f32x16 s0, s1;
#pragma unroll
            for (int i = 0; i < 16; ++i) { s0[i] = 0.f; s1[i] = 0.f; }
            const int kr0 = r, kr1 = 32 + r;
#pragma unroll
            for (int ks = 0; ks < NKS; ++ks) {
                bf16x8 kf0, kf1;
                if (ks < 4) {
                    kf0 = *(const bf16x8*)(sb + kr0 * 128 + (((2 * ks + h) ^ ((kr0 >> 1) & 7)) << 4));
                    kf1 = *(const bf16x8*)(sb + kr1 * 128 + (((2 * ks + h) ^ ((kr1 >> 1) & 7)) << 4));
                } else {
                    kf0 = *(const bf16x8*)(sb + 16384 + kr0 * 64 + (((2 * (ks - 4) + h) ^ ((kr0 >> 2) & 3)) << 4));
                    kf1 = *(const bf16x8*)(sb + 16384 + kr1 * 64 + (((2 * (ks - 4) + h) ^ ((kr1 >> 2) & 3)) << 4));
                }
                s0 = MFMA32(kf0, qf[ks], s0);
                s1 = MFMA32(kf1, qf[ks], s1);
            }
            float mx = -30000.0f;
            const bool need_mask = MASKED || (2 * j + 1 >= qb32);
            if (need_mask) {
                unsigned mb0 = 0xffffffffu, mb1 = (2 * j + 1 <= qb32) ? 0xffffffffu : 0u;
                if (MASKED) {
                    mb0 = *(const unsigned*)(sb + 16384 + w * 256 + r * 4) >> (4 * h);
                    const unsigned w1 = *(const unsigned*)(sb + 16384 + w * 256 + (32 + r) * 4) >> (4 * h);
                    mb1 = (2 * j + 1 <= qb32) ? w1 : 0u;
                }
                if (2 * j == qb32) mb0 &= cmask;
                if (2 * j + 1 == qb32) mb1 &= cmask;
#pragma unroll
                for (int i = 0; i < 16; ++i) {
                    const int ci = (i & 3) + 8 * (i >> 2);
                    const unsigned t0m = (unsigned)(((int)(mb0 << (31 - ci))) >> 31), t1m = (unsigned)(((int)(mb1 << (31 - ci))) >> 31);
                    s0[i] = __uint_as_float((t0m & __float_as_uint(s0[i])) | (~t0m & 0xc6ea6000u));
                    s1[i] = __uint_as_float((t1m & __float_as_uint(s1[i])) | (~t1m & 0xc6ea6000u));
                }
            }
            {
                float mxa = mx, mxb = mx;
#pragma unroll
                for (int i = 0; i < 16; i += 2) {
                    asm("v_max3_f32 %0, %1, %2, %3" : "=v"(mxa) : "v"(mxa), "v"(s0[i]), "v"(s1[i]));
                    asm("v_max3_f32 %0, %1, %2, %3" : "=v"(mxb) : "v"(mxb), "v"(s0[i + 1]), "v"(s1[i + 1]));
                }
                asm("v_max_f32 %0, %1, %2" : "=v"(mx) : "v"(mxa), "v"(mxb));
            }
            mx = xor32_max(mx);
            const float mnw = fmaxf(m, mx);
            const float al = __builtin_amdgcn_exp2f((m - mnw) * cscale);
            const float nmc = -mnw * cscale;
#pragma unroll
            for (int i = 0; i < 16; ++i) {
                s0[i] = __builtin_amdgcn_exp2f(fmaf(s0[i], cscale, nmc)); s1[i] = __builtin_amdgcn_exp2f(fmaf(s1[i], cscale, nmc));
            }
            if (__builtin_amdgcn_ballot_w64(mnw > m) != 0) {
#pragma unroll
                for (int i = 0; i < 16; ++i) { o0[i] *= al; o1[i] *= al; }
                o2[0] *= al;
            }
            m = mnw;
            u32x4 pk[4];
#pragma unroll
            for (int q = 0; q < 4; ++q) {
                pk[0][q] = cvt_pk_bf16(s0[2 * q], s0[2 * q + 1]); pk[1][q] = cvt_pk_bf16(s0[8 + 2 * q], s0[8 + 2 * q + 1]);
                pk[2][q] = cvt_pk_bf16(s1[2 * q], s1[2 * q + 1]); pk[3][q] = cvt_pk_bf16(s1[8 + 2 * q], s1[8 + 2 * q + 1]);
            }
#pragma unroll
            for (int kk = 0; kk < 4; ++kk) {
                const bf16x8 pb = __builtin_bit_cast(bf16x8, pk[kk]);
                bf16x8 vfr[1][2];
#pragma unroll
                for (int db = 0; db < 2; ++db) { const int d = 32 * db + r; vfr[0][db] = *(const bf16x8*)(sb + 8192 + d * 128 + (((2 * kk + h) ^ ((d >> 1) & 7)) << 4)); }
                o0 = MFMA32(vfr[0][0], pb, o0);
                o1 = MFMA32(vfr[0][1], pb, o1);
                o2 = MFMA32(ones, pb, o2);
            }
        }
      }
    }
    l = o2[0];
    const float inv = 1.f / l;
    bf16_t* op = outp + (size_t)(t0 + r) * 1024;
#pragma unroll
    for (int db = 0; db < 2; ++db) {
#pragma unroll
        for (int g = 0; g < 4; ++g) {
            const int d = 32 * db + 8 * g + 4 * h;
            const u32x2 gv = gpre[db][g];
            float v0, v1, v2, v3;
            if (db == 0) { v0 = o0[4 * g]; v1 = o0[4 * g + 1]; v2 = o0[4 * g + 2]; v3 = o0[4 * g + 3]; }
            else { v0 = o1[4 * g]; v1 = o1[4 * g + 1]; v2 = o1[4 * g + 2]; v3 = o1[4 * g + 3]; }
            v0 *= inv * __uint_as_float(gv[0] << 16); v1 *= inv * __uint_as_float(gv[0] & 0xffff0000u);
            v2 *= inv * __uint_as_float(gv[1] << 16); v3 *= inv * __uint_as_float(gv[1] & 0xffff0000u);
            u32x2 ov; ov[0] = cvt_pk_bf16(v0, v1); ov[1] = cvt_pk_bf16(v2, v3);
            *(u32x2*)(op + d) = ov;
        }
    }
}

__global__ void __launch_bounds__(512) mega(Params p) {
    cg::grid_group grid = cg::this_grid();
    extern __shared__ __attribute__((aligned(16))) char lds[];
    char* ws = p.ws;
    const int tid = threadIdx.x, G = gridDim.x, bid = blockIdx.x;

#ifndef SKIP_P0
    for (int rep = 0; rep < REP0; ++rep) {
        if (bid == 0 && tid == 0) __hip_atomic_store((unsigned*)(ws + OFF_BAR), 0u, __ATOMIC_RELAXED, __HIP_MEMORY_SCOPE_AGENT);
        float* tile = (float*)lds;
        auto do_transposes = [&]() {
            transpose_convert(p.w_in, DIN, 1024, NPAD, (bf16_t*)(ws + OFF_WINT), nullptr, MapIn{}, tile);
            transpose_convert(p.w_uq, 768, 256, 1024, (bf16_t*)(ws + OFF_WUQT), p.qg, MapUq{}, tile);
            transpose_convert(p.w_ukv, 1024, 128, 1024, (bf16_t*)(ws + OFF_WUKVT), p.kvg, MapId{}, tile);
            transpose_convert(p.w_out, 1024, 1024, 1024, (bf16_t*)(ws + OFF_WOUTT), nullptr, MapId{}, tile);
        };
        auto do_xconv = [&]() {
            const size_t n4 = (size_t)NTOK * DM / 4;
            u32x2* xb = (u32x2*)(ws + OFF_XB);
            const size_t stride = (size_t)G * 512;
            for (size_t i0 = (size_t)bid * 512 + tid; i0 < n4; i0 += stride * 16) {
                float4 v[16];
#pragma unroll
                for (int u = 0; u < 16; ++u) { const size_t i = i0 + u * stride; if (i < n4) v[u] = nt_load4(p.x + 4 * i); }
#pragma unroll
                for (int u = 0; u < 16; ++u) {
                    const size_t i = i0 + u * stride;
                    if (i < n4) { u32x2 o; o[0] = cvt_pk_bf16(v[u].x, v[u].y); o[1] = cvt_pk_bf16(v[u].z, v[u].w); xb[i] = o; }
                }
            }
        };
        auto do_rope = [&]() {
            float2* rope = (float2*)(ws + OFF_ROPE);
            for (int i = bid * 512 + tid; i < NTOK * 32; i += G * 512) {
                const int tok = i >> 5, f = i & 31;
                const float inv = powf(10000.0f, -(float)f / 32.0f);
                const float ang = (float)p.pos[tok] * inv;
                float sn, cs; sincosf(ang, &sn, &cs);
                rope[i] = make_float2(cs, sn);
            }
        };
        if ((bid >> 3) & 1) { do_xconv(); do_rope(); do_transposes(); }
        else { do_transposes(); do_xconv(); do_rope(); }
    }
#endif
    grid.sync();

    float* rs_s = (float*)(lds + 3 * G_STAGE);
    const int xcd = bid & 7, li = bid >> 3, nxb = G >> 3;
#ifndef SKIP_P1
    for (int rep = 0; rep < REP1; ++rep) {
        for (int t0_ = li; t0_ < 192; t0_ += nxb) {
            const int nst = 192 / nxb;
            const int t = ((xcd & 1) && (192 % nxb == 0)) ? (li + (nst - 1 - (t0_ - li) / nxb) * nxb) : t0_;
            const int mg = t / 52, rem = t % 52, nt4 = rem >> 2, mi = rem & 3;
            const int mt = xcd * 16 + mg * 4 + mi;
            EpiIn e; e.ws = ws; e.nt = 0;
            gemm256x256((const bf16_t*)(ws + OFF_XB), 1024, (const bf16_t*)(ws + OFF_WINT), 1024, 1024, mt * 256, nt4 * 256, lds, e);
        }
        if (li < 32) {
            const int t = 192 + (li >> 1), mg = t / 52, rem = t % 52, nt4 = rem >> 2, mi = rem & 3;
            const int mt = xcd * 16 + mg * 4 + mi, nt2 = nt4 * 2 + (li & 1);
            EpiIn e; e.ws = ws; e.nt = nt2;
            gemm256((const bf16_t*)(ws + OFF_XB), 1024, (const bf16_t*)(ws + OFF_WINT), 1024, 1024, mt * 256, nt2 * 128, lds, e);
        }
    }
#endif
    fast_grid_barrier((unsigned*)(ws + OFF_BAR), 1u * (unsigned)G);

    auto do_p2 = [&]() {
    for (int rep = 0; rep < REP2; ++rep)
    for (int t = bid; t < 256; t += G) {
        const int kind = t >> 7, mt = t & 127;
        if (kind == 0) {
            row_rms((const bf16_t*)(ws + OFF_CQ), 256, mt * 256, rs_s);
            for (int nt2 = 0; nt2 < 8; ++nt2) {
                EpiUq e{ws, nt2, rs_s, mt * 256};
                gemm256((const bf16_t*)(ws + OFF_CQ), 256, (const bf16_t*)(ws + OFF_WUQT), 256, 256, mt * 256, nt2 * 128, lds, e);
            }
        } else {
            row_rms((const bf16_t*)(ws + OFF_CKV), 128, mt * 256, rs_s);
            for (int nt2 = 0; nt2 < 8; ++nt2) {
                EpiUkv e{ws, nt2, rs_s, mt * 256};
                gemm256((const bf16_t*)(ws + OFF_CKV), 128, (const bf16_t*)(ws + OFF_WUKVT), 128, 128, mt * 256, nt2 * 128, lds, e);
            }
        }
    }
    };
    if ((bid >> 3) & 1) { indexer_stream(ws, lds, G, bid, REP3); do_p2(); }
    else { do_p2(); indexer_stream(ws, lds, G, bid, REP3); }
    fast_grid_barrier((unsigned*)(ws + OFF_BAR), 2u * (unsigned)G);

#ifndef SKIP_P4
    for (int rep = 0; rep < REP4; ++rep) {
        auto unit_of = [&](int rd, int& branch, AUnit& U) -> bool {
            int c, rest;
            if (G == 256) { if (rd >= 8) return false; rest = xcd * 32 + rd * 4 + (li >> 3); c = ((li & 7) + rd) & 7; }
            else { const int u = rd * G + bid; if (u >= 2048) return false; c = 7 - (u >> 8); rest = u & 255; }
            branch = rest >> 7;
            const int b = (rest >> 3) & 15, head = rest & 7;
            const size_t tokb = (size_t)b * SEQ;
            U.c = c;
            if (branch == 0) {
                U.q = (const bf16_t*)(ws + OFF_QA) + tokb * 512 + head * 64; U.k = (const bf16_t*)(ws + OFF_KA) + tokb * 512 + head * 64; U.kpe = nullptr;
                U.vt = (const bf16_t*)(ws + OFF_VTA) + (size_t)(b * 8 + head) * 64 * 2048; U.mwb = (const unsigned*)(ws + OFF_MASK) + (size_t)(b * 64) * 64 * 32;
                U.gate = (const bf16_t*)(ws + OFF_GATE) + tokb * 1024 + head * 64; U.out = (bf16_t*)(ws + OFF_XB) + tokb * 1024 + head * 64;
            } else {
                U.q = (const bf16_t*)(ws + OFF_QB) + tokb * 768 + head * 96; U.k = (const bf16_t*)(ws + OFF_KB) + tokb * 512 + head * 64; U.kpe = (const bf16_t*)(ws + OFF_KPE) + tokb * 32;
                U.vt = (const bf16_t*)(ws + OFF_VTB) + (size_t)(b * 8 + head) * 64 * 2048; U.mwb = nullptr;
                U.gate = (const bf16_t*)(ws + OFF_GATE) + tokb * 1024 + 512 + head * 64; U.out = (bf16_t*)(ws + OFF_XB) + tokb * 1024 + 512 + head * 64;
            }
            return true;
        };
        AUnit U, N; int br = 0, brn = 0, rd = 0;
        while (unit_of(rd, br, U)) {
            bool pre = false;
            if (br == 0) {
                for (;;) {
                    const bool chain = unit_of(rd + 1, brn, N) && brn == 0;
                    attn_block<64, true>(U, 512, 0.125f * 1.44269504089f, lds, pre, chain, N);
                    ++rd; if (!chain) break; pre = true; U = N;
                }
            } else {
                for (;;) {
                    const bool chain = unit_of(rd + 1, brn, N) && brn == 1;
                    attn_block<96, false>(U, 768, 0.10206207262f * 1.44269504089f, lds, pre, chain, N);
                    ++rd; if (!chain) break; pre = true; U = N;
                }
            }
        }
    }
#endif
    fast_grid_barrier((unsigned*)(ws + OFF_BAR), 3u * (unsigned)G);

#ifndef SKIP_P5
    for (int rep = 0; rep < REP5; ++rep)
    for (int t = li; t < 128; t += nxb) {
        const int mg = t >> 5, rem = t & 31, nt2 = rem >> 2, mi = rem & 3;
        const int mt = xcd * 16 + mg * 4 + mi;
        EpiOut e; e.x = p.x; e.out = p.out; e.n0 = nt2 * 128;
        gemm256((const bf16_t*)(ws + OFF_XB), 1024, (const bf16_t*)(ws + OFF_WOUTT), 1024, 1024, mt * 256, nt2 * 128, lds, e);
    }
#endif
    fast_grid_barrier((unsigned*)(ws + OFF_BAR), 4u * (unsigned)G);

    {
        const int lane = tid & 63, w = __builtin_amdgcn_readfirstlane(tid >> 6);
        const int NWv = G * 8, gw = bid * 8 + w;
        float4 gg[4], bb[4];
#pragma unroll
        for (int i = 0; i < 4; ++i) { gg[i] = ((const float4*)p.ln_g)[lane + 64 * i]; bb[i] = ((const float4*)p.ln_b)[lane + 64 * i]; }
        for (int row0 = gw * 4; row0 < NTOK; row0 += NWv * 4) {
            float4 v[4][4];
#pragma unroll
            for (int rr = 0; rr < 4; ++rr)
#pragma unroll
                for (int i = 0; i < 4; ++i) v[rr][i] = nt_load4(p.out + (size_t)(row0 + rr) * 1024 + 4 * (lane + 64 * i));
            float s[4], q[4];
#pragma unroll
            for (int rr = 0; rr < 4; ++rr) {
                s[rr] = 0.f;
#pragma unroll
                for (int i = 0; i < 4; ++i) s[rr] += v[rr][i].x + v[rr][i].y + v[rr][i].z + v[rr][i].w;
            }
#pragma unroll
            for (int off = 32; off >= 1; off >>= 1)
#pragma unroll
                for (int rr = 0; rr < 4; ++rr) s[rr] += __shfl_xor(s[rr], off);
#pragma unroll
            for (int rr = 0; rr < 4; ++rr) {
                const float mu = s[rr] * (1.f / 1024.f);
                q[rr] = 0.f;
#pragma unroll
                for (int i = 0; i < 4; ++i) {
                    v[rr][i].x -= mu; v[rr][i].y -= mu; v[rr][i].z -= mu; v[rr][i].w -= mu;
                    q[rr] += v[rr][i].x * v[rr][i].x + v[rr][i].y * v[rr][i].y + v[rr][i].z * v[rr][i].z + v[rr][i].w * v[rr][i].w;
                }
            }
#pragma unroll
            for (int off = 32; off >= 1; off >>= 1)
#pragma unroll
                for (int rr = 0; rr < 4; ++rr) q[rr] += __shfl_xor(q[rr], off);
#pragma unroll
            for (int rr = 0; rr < 4; ++rr) {
                const float rstd = __builtin_amdgcn_rsqf(q[rr] * (1.f / 1024.f) + 1e-5f);
#pragma unroll
                for (int i = 0; i < 4; ++i) {
                    float4 y; y.x = v[rr][i].x * rstd * gg[i].x + bb[i].x; y.y = v[rr][i].y * rstd * gg[i].y + bb[i].y;
                    y.z = v[rr][i].z * rstd * gg[i].z + bb[i].z; y.w = v[rr][i].w * rstd * gg[i].w + bb[i].w;
                    nt_store4(p.out + (size_t)(row0 + rr) * 1024 + 4 * (lane + 64 * i), y);
                }
            }
        }
    }
}

extern "C" void kernel_launch(void* const* d_in, const int* in_sizes, int n_in, void* d_out, int out_size, void* d_ws, size_t ws_size, hipStream_t stream) {
    static int grid_blocks = 0;
    if (!grid_blocks) {
        int dev = 0, cus = 0, per_cu = 0;
        hipGetDevice(&dev);
        hipDeviceGetAttribute(&cus, hipDeviceAttributeMultiprocessorCount, dev);
        if (hipFuncSetAttribute((const void*)mega, hipFuncAttributeMaxDynamicSharedMemorySize, LDS_BYTES) != hipSuccess) fprintf(stderr, "kernel_launch: hipFuncSetAttribute failed\n");
        if (hipOccupancyMaxActiveBlocksPerMultiprocessor(&per_cu, mega, 512, LDS_BYTES) != hipSuccess || per_cu < 1) per_cu = 1;
        if (per_cu > 1) per_cu = 1;
        grid_blocks = cus * per_cu;
        if (ws_size < WS_END) fprintf(stderr, "kernel_launch: workspace too small: %zu < %zu\n", ws_size, (size_t)WS_END);
    }
    Params p{};
    p.x = (const float*)d_in[0]; p.pos = (const int*)d_in[1]; p.w_in = (const float*)d_in[2]; p.qg = (const float*)d_in[3];
    p.w_uq = (const float*)d_in[4]; p.kvg = (const float*)d_in[5]; p.w_ukv = (const float*)d_in[6]; p.w_out = (const float*)d_in[7];
    p.ln_g = (const float*)d_in[8]; p.ln_b = (const float*)d_in[9]; p.out = (float*)d_out; p.ws = (char*)d_ws;
    void* args[] = {&p};
    hipError_t e = hipLaunchCooperativeKernel((const void*)mega, dim3(grid_blocks), dim3(512), args, LDS_BYTES, stream);
    if (e != hipSuccess) fprintf(stderr, "cooperative launch failed: %s (grid %d)\n", hipGetErrorString(e), grid_blocks);
}
```

```cpp
#include <hip/hip_runtime.h>
#include <hip/hip_cooperative_groups.h>
#include <cstdio>
#include <cstdint>
namespace cg = cooperative_groups;
#ifndef REP0
#define REP0 1
#endif
#ifndef REP1
#define REP1 1
#endif
#ifndef REP2
#define REP2 1
#endif
#ifndef REP3
#define REP3 1
#endif
#ifndef REP4
#define REP4 1
#endif
#ifndef REP5
#define REP5 1
#endif
#ifndef REP6
#define REP6 1
#endif

#define DI __device__ __forceinline__
typedef unsigned short bf16_t;
typedef short bf16x8 __attribute__((ext_vector_type(8)));
typedef short s16x4 __attribute__((ext_vector_type(4)));
typedef float f32x16 __attribute__((ext_vector_type(16)));
typedef unsigned u32x4 __attribute__((ext_vector_type(4)));
typedef unsigned u32x2 __attribute__((ext_vector_type(2)));
typedef float f32x4v __attribute__((ext_vector_type(4)));
DI float4 nt_load4(const float* p) { const f32x4v v = __builtin_nontemporal_load((const f32x4v*)p); return make_float4(v[0], v[1], v[2], v[3]); }
DI void nt_store4(float* p, float4 y) { f32x4v v = {y.x, y.y, y.z, y.w}; __builtin_nontemporal_store(v, (f32x4v*)p); }

constexpr int NB = 16, SEQ = 2048, NTOK = NB * SEQ, DM = 1024, DIN = 3272, NPAD = 3328;
constexpr float ALPHA = 1.189207115002721f;

constexpr size_t al256(size_t x) { return (x + 255) & ~(size_t)255; }
constexpr size_t OFF_WINT = 0;
constexpr size_t OFF_WUQT = OFF_WINT + al256((size_t)NPAD * 1024 * 2);
constexpr size_t OFF_WUKVT = OFF_WUQT + al256((size_t)1024 * 256 * 2);
constexpr size_t OFF_WOUTT = OFF_WUKVT + al256((size_t)1024 * 128 * 2);
constexpr size_t OFF_XB = OFF_WOUTT + al256((size_t)1024 * 1024 * 2);
constexpr size_t OFF_ROPE = OFF_XB + al256((size_t)NTOK * 1024 * 2);
constexpr size_t OFF_QA = OFF_ROPE + al256((size_t)NTOK * 32 * 8);
constexpr size_t OFF_KA = OFF_QA + al256((size_t)NTOK * 512 * 2);
constexpr size_t OFF_VTA = OFF_KA + al256((size_t)NTOK * 512 * 2);
constexpr size_t OFF_GATE = OFF_VTA + al256((size_t)NTOK * 512 * 2);
constexpr size_t OFF_IQ = OFF_GATE + al256((size_t)NTOK * 1024 * 2);
constexpr size_t OFF_IK = OFF_IQ + al256((size_t)NTOK * 256 * 2);
constexpr size_t OFF_IW = OFF_IK + al256((size_t)NTOK * 32 * 2);
constexpr size_t OFF_CQ = OFF_IW + al256((size_t)NTOK * 8 * 4);
constexpr size_t OFF_CKV = OFF_CQ + al256((size_t)NTOK * 256 * 2);
constexpr size_t OFF_KPE = OFF_CKV + al256((size_t)NTOK * 128 * 2);
constexpr size_t OFF_QB = OFF_KPE + al256((size_t)NTOK * 32 * 2);
constexpr size_t OFF_KB = OFF_QB + al256((size_t)NTOK * 768 * 2);
constexpr size_t OFF_VTB = OFF_KB + al256((size_t)NTOK * 512 * 2);
constexpr size_t OFF_MASK = OFF_VTB + al256((size_t)NTOK * 512 * 2);
constexpr size_t OFF_BAR = OFF_MASK + al256((size_t)NB * 64 * 64 * 32 * 4);
constexpr size_t WS_END = OFF_BAR + 256;

struct Params {
    const float* x; const int* pos; const float* w_in; const float* qg; const float* w_uq; const float* kvg;
    const float* w_ukv; const float* w_out; const float* ln_g; const float* ln_b; float* out; char* ws;
};

DI void lds_barrier() { __builtin_amdgcn_fence(__ATOMIC_RELEASE, "workgroup", "local"); __builtin_amdgcn_s_barrier(); __builtin_amdgcn_fence(__ATOMIC_ACQUIRE, "workgroup", "local"); }
DI void fast_grid_barrier(unsigned* ctr, unsigned target) {
    asm volatile("s_waitcnt vmcnt(0)" ::: "memory");
    __syncthreads();
    if (threadIdx.x == 0) {
        __builtin_amdgcn_fence(__ATOMIC_RELEASE, "agent");
        asm volatile("s_waitcnt vmcnt(0)" ::: "memory");
        __hip_atomic_fetch_add(ctr, 1u, __ATOMIC_RELAXED, __HIP_MEMORY_SCOPE_AGENT);
        unsigned spins = 0;
        while (__hip_atomic_load(ctr, __ATOMIC_RELAXED, __HIP_MEMORY_SCOPE_AGENT) < target && ++spins < (1u << 22)) __builtin_amdgcn_s_sleep(2);
        __builtin_amdgcn_fence(__ATOMIC_ACQUIRE, "agent");
        asm volatile("s_waitcnt vmcnt(0)" ::: "memory");
    }
    __syncthreads();
}
DI int crow(int i, int h) { return (i & 3) + 8 * (i >> 2) + 4 * h; }
typedef float f32x2v __attribute__((ext_vector_type(2)));
typedef __bf16 bf16x2v __attribute__((ext_vector_type(2)));
DI unsigned cvt_pk_bf16(float lo, float hi) { const f32x2v v = {lo, hi}; const bf16x2v b = __builtin_convertvector(v, bf16x2v); return __builtin_bit_cast(unsigned, b); }
DI bf16_t f2bf(float x) { return (bf16_t)(cvt_pk_bf16(x, 0.f) & 0xffffu); }
DI float bf2f(unsigned short v) { return __uint_as_float(((unsigned)v) << 16); }
DI float silu(float x) { return x * __builtin_amdgcn_rcpf(1.f + __builtin_amdgcn_exp2f(-1.44269504089f * x)); }
DI float xor32_max(float x) { auto t = __builtin_amdgcn_permlane32_swap(__float_as_uint(x), __float_as_uint(x), false, false); return fmaxf(__uint_as_float(t[0]), __uint_as_float(t[1])); }
DI float xor32_sum(float x) { auto t = __builtin_amdgcn_permlane32_swap(__float_as_uint(x), __float_as_uint(x), false, false); return __uint_as_float(t[0]) + __uint_as_float(t[1]); }
DI int xrow16_sum_i(int x) {
    auto s = __builtin_amdgcn_permlane16_swap((unsigned)x, (unsigned)x, false, false);
    x = (int)(s[0] + s[1]);
    auto t = __builtin_amdgcn_permlane32_swap((unsigned)x, (unsigned)x, false, false);
    return (int)(t[0] + t[1]);
}
DI unsigned xrow16_or(unsigned x) {
    auto s = __builtin_amdgcn_permlane16_swap(x, x, false, false);
    x = s[0] | s[1];
    auto t = __builtin_amdgcn_permlane32_swap(x, x, false, false);
    return t[0] | t[1];
}
template <int CTRL> DI int dpp_i(int x) { return __builtin_amdgcn_mov_dpp(x, CTRL, 0xf, 0xf, true); }
DI int wave_sum_i(int x) {
    x += dpp_i<0xB1>(x);
    x += dpp_i<0x4E>(x);
    x += dpp_i<0x141>(x);
    x += dpp_i<0x140>(x);
    return xrow16_sum_i(x);
}
#define CNT4(c0, c1, c2, c3, k0, k1, k2, k3, cand) do { unsigned long long t0_, t1_, t2_, t3_; \
    asm("v_cmp_le_u32_e64 %4, %12, %8\n\tv_cmp_le_u32_e64 %5, %12, %9\n\tv_cmp_le_u32_e64 %6, %12, %10\n\tv_cmp_le_u32_e64 %7, %12, %11\n\t" \
        "v_addc_co_u32_e64 %0, %4, %0, 0, %4\n\tv_addc_co_u32_e64 %1, %5, %1, 0, %5\n\tv_addc_co_u32_e64 %2, %6, %2, 0, %6\n\tv_addc_co_u32_e64 %3, %7, %3, 0, %7" \
        : "+v"(c0), "+v"(c1), "+v"(c2), "+v"(c3), "=&s"(t0_), "=&s"(t1_), "=&s"(t2_), "=&s"(t3_) \
        : "v"(k0), "v"(k1), "v"(k2), "v"(k3), "s"(cand)); } while (0)
#define MFMA32(a, b, c) __builtin_amdgcn_mfma_f32_32x32x16_bf16((a), (b), (c), 0, 0, 0)

struct MapIn { DI int operator()(int p) const {
    if (p < 2048) return p;
    if (p < 2304) { int q = p - 2048, gq = q >> 6, c = q & 63, half = c >> 5, hh = (c & 31) >> 4, i = c & 15; return 2048 + (2 * gq + hh) * 32 + half * 16 + i; }
    if (p < 2368) { int c = p - 2304, half = c >> 5, sub = (c & 31) >> 4, i = c & 15; return (sub ? 2728 : 2304) + half * 16 + i; }
    if (p < 2432) { int c = p - 2368; return c < 8 ? 2336 + c : -1; }
    if (p < 2688) return 2344 + (p - 2432);
    if (p < 2816) return 2600 + (p - 2688);
    return 2760 + (p - 2816);
} };
struct MapUq { DI int operator()(int p) const {
    int head = p >> 7, c = p & 127;
    if (c < 64) return head * 96 + c;
    int c2 = c - 64, half = c2 >> 5, i = c2 & 31;
    return i < 16 ? head * 96 + 64 + half * 16 + i : -1;
} };
struct MapId { DI int operator()(int p) const { return p; } };

template <class Map>
DI void transpose_convert(const float* __restrict__ src, int ldsrc, int K, int P, bf16_t* __restrict__ dst, const float* __restrict__ kscale, Map map, float* tile) {
    const int tid = threadIdx.x;
    const int tilesK = K >> 6, tilesP = P >> 6;
    for (int t = blockIdx.x; t < tilesK * tilesP; t += gridDim.x) {
        const int tk = t % tilesK, tp = t / tilesK;
        const int c = tid & 63, r0 = tid >> 6;
        const int oc = map(tp * 64 + c);
        __syncthreads();
#pragma unroll
        for (int i = 0; i < 8; ++i) {
            const int r = r0 + 8 * i, k = tk * 64 + r;
            float v = oc >= 0 ? src[(size_t)k * ldsrc + oc] : 0.f;
            if (kscale) v *= kscale[k];
            tile[r * 65 + c] = v;
        }
        __syncthreads();
        const int prow = tid >> 3, kseg = (tid & 7) * 8;
        u32x4 o;
#pragma unroll
        for (int j = 0; j < 4; ++j) o[j] = cvt_pk_bf16(tile[(kseg + 2 * j) * 65 + prow], tile[(kseg + 2 * j + 1) * 65 + prow]);
        *(u32x4*)(dst + (size_t)(tp * 64 + prow) * K + tk * 64 + kseg) = o;
    }
}

constexpr int G_STAGE = 49152;
constexpr int LDS_BYTES = 3 * G_STAGE + 2048;
#define RAW_BARRIER() do { asm volatile("s_waitcnt lgkmcnt(0)" ::: "memory"); __builtin_amdgcn_s_barrier(); } while (0)
DI void glds16(const bf16_t* g, char* l) { __builtin_amdgcn_global_load_lds((const unsigned*)g, (unsigned*)l, 16, 0, 0); }
template <class Epi>
DI void gemm256(const bf16_t* __restrict__ A, int lda, const bf16_t* __restrict__ Bt, int ldb, int K, int m0, int n0, char* lds, Epi epi) {
    const int tid = threadIdx.x, lane = tid & 63, w = __builtin_amdgcn_readfirstlane(tid >> 6), wm = w >> 1, wn = w & 1, r = lane & 31, h = lane >> 5;
    const int lr = lane >> 3, lp = lane & 7;
    auto issue = [&](int kt, int st) {
        char* sb = lds + st * G_STAGE;
#pragma unroll
        for (int i = 0; i < 4; ++i) {
            const int rowb = (w * 4 + i) * 8, row = rowb + lr, c = lp ^ ((row >> 1) & 7);
            glds16(A + (size_t)(m0 + row) * lda + kt * 64 + c * 8, sb + rowb * 128);
        }
#pragma unroll
        for (int i = 0; i < 2; ++i) {
            const int rowb = (w * 2 + i) * 8, row = rowb + lr, c = lp ^ ((row >> 1) & 7);
            glds16(Bt + (size_t)(n0 + row) * ldb + kt * 64 + c * 8, sb + 32768 + rowb * 128);
        }
    };
    f32x16 acc[2][2];
#pragma unroll
    for (int a = 0; a < 2; ++a)
#pragma unroll
        for (int b = 0; b < 2; ++b)
#pragma unroll
            for (int i = 0; i < 16; ++i) acc[a][b][i] = 0.f;
    const int nk = K >> 6;
    epi.prefetch(m0 + 64 * wm, wn, r, h);
    RAW_BARRIER();
    issue(0, 0);
    if (nk > 1) issue(1, 1);
#pragma unroll 1
    for (int kt = 0; kt < nk; ++kt) {
        if (kt + 1 < nk) asm volatile("s_waitcnt vmcnt(6)" ::: "memory"); else asm volatile("s_waitcnt vmcnt(0)" ::: "memory");
        RAW_BARRIER();
        if (kt + 2 < nk) issue(kt + 2, (kt + 2) % 3);
        const char* sa = lds + (kt % 3) * G_STAGE;
        const char* sbb = sa + 32768;
#pragma unroll
        for (int ks = 0; ks < 4; ++ks) {
            bf16x8 af[2], bfr[2];
#pragma unroll
            for (int mi = 0; mi < 2; ++mi) { const int row = 64 * wm + 32 * mi + r; af[mi] = *(const bf16x8*)(sa + row * 128 + (((2 * ks + h) ^ ((row >> 1) & 7)) << 4)); }
#pragma unroll
            for (int j = 0; j < 2; ++j) { const int row = 64 * wn + 32 * j + r; bfr[j] = *(const bf16x8*)(sbb + row * 128 + (((2 * ks + h) ^ ((row >> 1) & 7)) << 4)); }
#pragma unroll
            for (int mi = 0; mi < 2; ++mi)
#pragma unroll
                for (int j = 0; j < 2; ++j) acc[mi][j] = MFMA32(af[mi], bfr[j], acc[mi][j]);
        }
    }
    epi(acc[0][0], acc[0][1], m0 + 64 * wm, wn, r, h, 0);
    epi(acc[1][0], acc[1][1], m0 + 64 * wm + 32, wn, r, h, 1);
}

constexpr int G2_STAGE = 32768;
template <class Epi>
DI void gemm256x256(const bf16_t* __restrict__ A, int lda, const bf16_t* __restrict__ Bt, int ldb, int K, int m0, int n0, char* lds, Epi epi) {
    const int tid = threadIdx.x, lane = tid & 63, w = __builtin_amdgcn_readfirstlane(tid >> 6), wm = w >> 1, wn = w & 1, r = lane & 31, h = lane >> 5;
    const int lr = lane >> 2, lp = lane & 3;
    auto issue = [&](int kt, int st) {
        char* sb = lds + st * G2_STAGE;
#pragma unroll
        for (int i = 0; i < 2; ++i) {
            const int rowb = (w * 2 + i) * 16, row = rowb + lr, c = lp ^ ((row >> 2) & 3);
            glds16(A + (size_t)(m0 + row) * lda + kt * 32 + c * 8, sb + rowb * 64);
            glds16(Bt + (size_t)(n0 + row) * ldb + kt * 32 + c * 8, sb + 16384 + rowb * 64);
        }
    };
    f32x16 acc[2][4];
#pragma unroll
    for (int a = 0; a < 2; ++a)
#pragma unroll
        for (int b = 0; b < 4; ++b)
#pragma unroll
            for (int i = 0; i < 16; ++i) acc[a][b][i] = 0.f;
    const int nk = K >> 5;
    const int grp0 = (n0 >> 6) + 2 * wn;
    epi.prefetch_mi(m0 + 64 * wm, grp0, r, h, 0);
    RAW_BARRIER();
    issue(0, 0); issue(1, 1); issue(2, 2);
#pragma unroll 2
    for (int kt = 0; kt < nk; ++kt) {
        if (kt + 2 < nk) asm volatile("s_waitcnt vmcnt(8)" ::: "memory");
        else if (kt + 1 < nk) asm volatile("s_waitcnt vmcnt(4)" ::: "memory");
        else asm volatile("s_waitcnt vmcnt(0)" ::: "memory");
        RAW_BARRIER();
        if (kt + 3 < nk) issue(kt + 3, (kt + 3) & 3);
        const char* sa = lds + (kt & 3) * G2_STAGE;
        const char* sbb = sa + 16384;
#pragma unroll
        for (int ks = 0; ks < 2; ++ks) {
            bf16x8 af[2], bfr[4];
#pragma unroll
            for (int mi = 0; mi < 2; ++mi) { const int row = 64 * wm + 32 * mi + r; af[mi] = *(const bf16x8*)(sa + row * 64 + (((2 * ks + h) ^ ((row >> 2) & 3)) << 4)); }
#pragma unroll
            for (int j = 0; j < 4; ++j) { const int row = 128 * wn + 32 * j + r; bfr[j] = *(const bf16x8*)(sbb + row * 64 + (((2 * ks + h) ^ ((row >> 2) & 3)) << 4)); }
#pragma unroll
            for (int mi = 0; mi < 2; ++mi)
#pragma unroll
                for (int j = 0; j < 4; ++j) acc[mi][j] = MFMA32(af[mi], bfr[j], acc[mi][j]);
        }
    }
    epi(acc[0][0], acc[0][1], m0 + 64 * wm, grp0, r, h, 0);
    epi.prefetch_mi(m0 + 64 * wm, grp0, r, h, 1);
    epi(acc[0][2], acc[0][3], m0 + 64 * wm, grp0 + 1, r, h, 0);
    epi(acc[1][0], acc[1][1], m0 + 64 * wm + 32, grp0, r, h, 1);
    epi(acc[1][2], acc[1][3], m0 + 64 * wm + 32, grp0 + 1, r, h, 1);
}

DI void store_vt4(bf16_t* vt, int head, int d, int row, float a, float b, float c, float e) {
    const int bb = row >> 11, s0_ = row & 2047, s = (s0_ & ~12) | ((s0_ & 4) << 1) | ((s0_ & 8) >> 1);
    u32x2 v; v[0] = cvt_pk_bf16(a, b); v[1] = cvt_pk_bf16(c, e);
    *(u32x2*)(vt + (unsigned)(((bb * 8 + head) * 64 + d) * 2048 + s)) = v;
}

struct EpiIn {
    char* ws; int nt; float2 pcs[2][16];
    DI void prefetch_mi(int row0, int wn, int r, int h, int mi) {
        const int grp = nt * 2 + wn;
        const float2* rope = (const float2*)(ws + OFF_ROPE);
        if (grp < 16 || (grp >= 32 && grp < 37)) {
            const int idx = grp < 16 ? r : 2 * (r & 15);
#pragma unroll
            for (int i = 0; i < 16; ++i) {
                const float2 v = rope[(unsigned)(row0 + 32 * mi + crow(i, h)) * 32u + idx];
                if (mi) pcs[1][i] = v; else pcs[0][i] = v;
            }
        }
    }
    DI void prefetch(int row0, int wn, int r, int h) { prefetch_mi(row0, wn, r, h, 0); prefetch_mi(row0, wn, r, h, 1); }
    DI void operator()(const f32x16& a0, const f32x16& a1, int row0, int wn, int r, int h, int mi) {
        const int grp = nt * 2 + wn;
        if (grp < 16) {
            bf16_t* dst = (bf16_t*)(ws + (grp < 8 ? OFF_QA : OFF_KA));
            const int head = grp & 7;
#pragma unroll
            for (int i = 0; i < 16; ++i) {
                const int row = row0 + crow(i, h);
                const float2 cs = mi ? pcs[1][i] : pcs[0][i];
                const float x1 = a0[i], x2 = a1[i];
                dst[(unsigned)row * 512u + head * 64 + r] = f2bf(x1 * cs.x - x2 * cs.y);
                dst[(unsigned)row * 512u + head * 64 + 32 + r] = f2bf(x1 * cs.y + x2 * cs.x);
            }
        } else if (grp < 24) {
            bf16_t* vt = (bf16_t*)(ws + OFF_VTA);
            const int head = grp - 16;
#pragma unroll
            for (int g = 0; g < 4; ++g) {
                const int row = row0 + 8 * g + 4 * h;
                store_vt4(vt, head, r, row, a0[4 * g], a0[4 * g + 1], a0[4 * g + 2], a0[4 * g + 3]);
                store_vt4(vt, head, 32 + r, row, a1[4 * g], a1[4 * g + 1], a1[4 * g + 2], a1[4 * g + 3]);
            }
        } else if (grp < 32 || grp >= 44) {
            bf16_t* gate = (bf16_t*)(ws + OFF_GATE);
            const int cb = grp < 32 ? (grp - 24) * 64 : 512 + (grp - 44) * 64;
#pragma unroll
            for (int i = 0; i < 16; ++i) {
                const int row = row0 + crow(i, h);
                gate[(unsigned)row * 1024u + cb + r] = f2bf(silu(a0[i]));
                gate[(unsigned)row * 1024u + cb + 32 + r] = f2bf(silu(a1[i]));
            }
        } else if (grp < 37) {
            const int hh = r >> 4, i16 = r & 15;
            bf16_t* dst; int ld, cb;
            if (grp < 36) { dst = (bf16_t*)(ws + OFF_IQ); ld = 256; cb = (2 * (grp - 32) + hh) * 32; }
            else { dst = (bf16_t*)(ws + (hh ? OFF_KPE : OFF_IK)); ld = 32; cb = 0; }
#pragma unroll
            for (int i = 0; i < 16; ++i) {
                const int row = row0 + crow(i, h);
                const float2 cs = mi ? pcs[1][i] : pcs[0][i];
                const float x1 = a0[i], x2 = a1[i];
                dst[(unsigned)row * (unsigned)ld + cb + i16] = f2bf(x1 * cs.x - x2 * cs.y);
                dst[(unsigned)row * (unsigned)ld + cb + 16 + i16] = f2bf(x1 * cs.y + x2 * cs.x);
            }
        } else if (grp == 37) {
            float* iw = (float*)(ws + OFF_IW);
            if (r < 8) {
#pragma unroll
                for (int i = 0; i < 16; ++i) iw[(unsigned)(row0 + crow(i, h)) * 8u + r] = a0[i] * 0.0625f;
            }
        } else {
            bf16_t* dst; int ld, cb;
            if (grp < 42) { dst = (bf16_t*)(ws + OFF_CQ); ld = 256; cb = (grp - 38) * 64; }
            else { dst = (bf16_t*)(ws + OFF_CKV); ld = 128; cb = (grp - 42) * 64; }
#pragma unroll
            for (int i = 0; i < 16; ++i) {
                const int row = row0 + crow(i, h);
                dst[(unsigned)row * (unsigned)ld + cb + r] = f2bf(a0[i]);
                dst[(unsigned)row * (unsigned)ld + cb + 32 + r] = f2bf(a1[i]);
            }
        }
    }
};

struct EpiUq {
    char* ws; int head; const float* rs; int m0;
    DI void prefetch(int, int, int, int) {}
    DI void operator()(const f32x16& a0, const f32x16& a1, int row0, int wn, int r, int h, int) const {
        bf16_t* qb = (bf16_t*)(ws + OFF_QB);
        const float2* rope = (const float2*)(ws + OFF_ROPE);
        if (wn == 0) {
#pragma unroll
            for (int i = 0; i < 16; ++i) {
                const int row = row0 + crow(i, h); const float s = rs[row - m0];
                qb[(size_t)row * 768 + head * 96 + r] = f2bf(a0[i] * s);
                qb[(size_t)row * 768 + head * 96 + 32 + r] = f2bf(a1[i] * s);
            }
        } else if (r < 16) {
#pragma unroll
            for (int i = 0; i < 16; ++i) {
                const int row = row0 + crow(i, h); const float s = rs[row - m0];
                const float2 cs = rope[(size_t)row * 32 + 2 * r];
                const float x1 = a0[i] * s, x2 = a1[i] * s;
                qb[(size_t)row * 768 + head * 96 + 64 + r] = f2bf(x1 * cs.x - x2 * cs.y);
                qb[(size_t)row * 768 + head * 96 + 80 + r] = f2bf(x1 * cs.y + x2 * cs.x);
            }
        }
    }
};
struct EpiUkv {
    char* ws; int head; const float* rs; int m0;
    DI void prefetch(int, int, int, int) {}
    DI void operator()(const f32x16& a0, const f32x16& a1, int row0, int wn, int r, int h, int) const {
        if (wn == 0) {
            bf16_t* kb = (bf16_t*)(ws + OFF_KB);
#pragma unroll
            for (int i = 0; i < 16; ++i) {
                const int row = row0 + crow(i, h); const float s = rs[row - m0];
                kb[(size_t)row * 512 + head * 64 + r] = f2bf(a0[i] * s);
                kb[(size_t)row * 512 + head * 64 + 32 + r] = f2bf(a1[i] * s);
            }
        } else {
            bf16_t* vt = (bf16_t*)(ws + OFF_VTB);
#pragma unroll
            for (int g = 0; g < 4; ++g) {
                const int row = row0 + 8 * g + 4 * h;
                const float s0 = rs[row - m0], s1 = rs[row - m0 + 1], s2 = rs[row - m0 + 2], s3 = rs[row - m0 + 3];
                store_vt4(vt, head, r, row, a0[4 * g] * s0, a0[4 * g + 1] * s1, a0[4 * g + 2] * s2, a0[4 * g + 3] * s3);
                store_vt4(vt, head, 32 + r, row, a1[4 * g] * s0, a1[4 * g + 1] * s1, a1[4 * g + 2] * s2, a1[4 * g + 3] * s3);
            }
        }
    }
};
DI void row_rms(const bf16_t* A, int K, int m0, float* rs) {
    const int tid = threadIdx.x, row = tid >> 1, part = tid & 1, n = K >> 1;
    const bf16_t* p = A + (size_t)(m0 + row) * K + part * n;
    float s = 0.f;
    for (int j = 0; j < n; j += 8) {
        const u32x4 v = *(const u32x4*)(p + j);
#pragma unroll
        for (int q = 0; q < 4; ++q) { const float lo = __uint_as_float(v[q] << 16), hi = __uint_as_float(v[q] & 0xffff0000u); s += lo * lo + hi * hi; }
    }
    s += __shfl_xor(s, 1);
    __syncthreads();
    if (part == 0) rs[row] = __builtin_amdgcn_rsqf(s / (float)K + 1e-6f);
}

struct EpiOut {
    const float* x; float* out; int n0; float xv[2][2][16];
    DI void prefetch(int row0, int wn, int r, int h) {
#pragma unroll
        for (int mi = 0; mi < 2; ++mi)
#pragma unroll
            for (int i = 0; i < 16; ++i) {
                const size_t o = (size_t)(row0 + 32 * mi + crow(i, h)) * 1024 + n0 + 64 * wn + r;
                xv[mi][0][i] = x[o]; xv[mi][1][i] = x[o + 32];
            }
    }
    DI void operator()(const f32x16& a0, const f32x16& a1, int row0, int wn, int r, int h, int mi) {
#pragma unroll
        for (int i = 0; i < 16; ++i) {
            const size_t o = (size_t)(row0 + crow(i, h)) * 1024 + n0 + 64 * wn + r;
            out[o] = ALPHA * (mi ? xv[1][0][i] : xv[0][0][i]) + a0[i];
            out[o + 32] = ALPHA * (mi ? xv[1][1][i] : xv[0][1][i]) + a1[i];
        }
    }
};

typedef float f32x4 __attribute__((ext_vector_type(4)));
#define MFMA16(a, b, c) __builtin_amdgcn_mfma_f32_16x16x32_bf16((a), (b), (c), 0, 0, 0)
DI void indexer_stream(char* ws, char* lds, int G, int bid, int nrep) {
    constexpr int KMS = 2052;
    bf16_t* iqs = (bf16_t*)lds;
    unsigned* KM = (unsigned*)(lds + 16 * 264 * 2);
    const int tid = threadIdx.x, lane = tid & 63, w = __builtin_amdgcn_readfirstlane(tid >> 6), q = lane & 15, g = lane >> 4;
    const bf16_t* iq = (const bf16_t*)(ws + OFF_IQ);
    const bf16_t* ik = (const bf16_t*)(ws + OFF_IK);
    const float* iw = (const float*)(ws + OFF_IW);
    unsigned* maskw = (unsigned*)(ws + OFF_MASK);
    const int nrounds = (2048 + G - 1) / G, total = nrounds * nrep;
    auto unit_of = [&](int it, int& ub, int& uq) -> bool {
        if (it >= total) return false;
        const int rd = it % nrounds;
        const int u = (rd & 1) ? rd * G + (G - 1 - bid) : rd * G + bid;
        if (u >= 2048) return false;
        ub = u & 15; uq = 127 - (u >> 4);
        return true;
    };
    u32x4 iqrow; float wv[8]; bf16x8 af[16];
    auto load_inputs = [&](int ub, int uq) {
        const int tk0 = ub * SEQ + uq * 16;
        iqrow = *(const u32x4*)(iq + (size_t)(tk0 + (tid >> 5)) * 256 + (tid & 31) * 8);
        const float4 w0 = *(const float4*)(iw + (size_t)(tk0 + q) * 8), w1 = *(const float4*)(iw + (size_t)(tk0 + q) * 8 + 4);
        wv[0] = w0.x; wv[1] = w0.y; wv[2] = w0.z; wv[3] = w0.w; wv[4] = w1.x; wv[5] = w1.y; wv[6] = w1.z; wv[7] = w1.w;
#pragma unroll
        for (int jj = 0; jj < 16; ++jj) {
            const int kt = 2 * (w + 8 * (jj >> 1)) + (jj & 1);
            if (kt < uq + 1) af[jj] = *(const bf16x8*)(ik + (size_t)(ub * SEQ + kt * 16 + q) * 32 + 8 * g);
        }
    };
    int b = 0, qb16 = 0;
    bool have = unit_of(0, b, qb16);
    if (have) load_inputs(b, qb16);
  for (int it = 0; have; ++it) {
    const int ntiles = qb16 + 1;
    lds_barrier();
    *(u32x4*)(iqs + (tid >> 5) * 264 + (tid & 31) * 8) = iqrow;
    lds_barrier();
    bf16x8 bqr[8];
#pragma unroll
    for (int hd = 0; hd < 8; ++hd) bqr[hd] = *(const bf16x8*)(iqs + q * 264 + hd * 32 + 8 * g);
#pragma unroll
    for (int jj = 0; jj < 16; ++jj) {
        const int kt = 2 * (w + 8 * (jj >> 1)) + (jj & 1);
        if (kt < ntiles) {
            const int s0 = kt * 16;
            const int vlim = qb16 * 16 + q - s0 - 4 * g;
            const bf16x8 a = af[jj];
            f32x4 sc = {0.f, 0.f, 0.f, 0.f};
#pragma unroll
            for (int hd = 0; hd < 8; ++hd) {
                const bf16x8 bq = bqr[hd];
                f32x4 t = {0.f, 0.f, 0.f, 0.f};
                t = MFMA16(a, bq, t);
#pragma unroll
                for (int i = 0; i < 4; ++i) sc[i] = fmaf(wv[hd], fmaxf(t[i], 0.f), sc[i]);
            }
            u32x4 kv;
#pragma unroll
            for (int i = 0; i < 4; ++i) {
                const float xx = sc[i] + 0.0f;
                const unsigned u = __float_as_uint(xx);
                const unsigned k = u ^ ((unsigned)((int)u >> 31) | 0x80000000u);
                kv[i] = (i <= vlim) ? k : 0u;
            }
            *(u32x4*)(KM + q * KMS + s0 + 4 * g) = kv;
        }
    }
    int nb = 0, nq = 0;
    const bool hn = unit_of(it + 1, nb, nq);
    if (hn) load_inputs(nb, nq);
    lds_barrier();
    const int nk = ntiles * 16;
    unsigned KA[32], KB[32];
#pragma unroll
    for (int i = 0; i < 32; ++i) {
        const int idx = 64 * i + lane;
        KA[i] = 0u; KB[i] = 0u;
        if (64 * i < nk) {
            const bool in = idx < nk;
            const unsigned va = KM[(2 * w) * KMS + (in ? idx : 0)], vb = KM[(2 * w + 1) * KMS + (in ? idx : 0)];
            KA[i] = in ? va : 0u; KB[i] = in ? vb : 0u;
        }
    }
    unsigned TA = 0, TB = 0; int cgeA = 2048, cgeB = 2048;
    const int nvalA = qb16 * 16 + 2 * w + 1, nvalB = nvalA + 1;
    bool doneA = nvalA <= 256, doneB = nvalB <= 256;
    for (int bit = 31; bit >= 0; --bit) {
        if (doneA && doneB) break;
        const unsigned candA = TA | (1u << bit), candB = TB | (1u << bit);
        int a0 = 0, a1 = 0, a2 = 0, a3 = 0, b0 = 0, b1 = 0, b2 = 0, b3 = 0;
#pragma unroll
        for (int gq = 0; gq < 4; ++gq) {
            if (512 * gq < nk) {
#pragma unroll
                for (int i = 8 * gq; i < 8 * gq + 8; i += 4) {
                    CNT4(a0, a1, a2, a3, KA[i], KA[i + 1], KA[i + 2], KA[i + 3], candA);
                    CNT4(b0, b1, b2, b3, KB[i], KB[i + 1], KB[i + 2], KB[i + 3], candB);
                }
            }
        }
        const int cA = __builtin_amdgcn_readfirstlane(wave_sum_i((a0 + a1) + (a2 + a3)));
        const int cB = __builtin_amdgcn_readfirstlane(wave_sum_i((b0 + b1) + (b2 + b3)));
        if (!doneA && cA >= 256) { TA = candA; cgeA = cA; doneA = (cA == 256); }
        if (!doneB && cB >= 256) { TB = candB; cgeB = cB; doneB = (cB == 256); }
    }
    const int qb32 = qb16 >> 1;
#pragma unroll
    for (int qq = 0; qq < 2; ++qq) {
        const unsigned T = qq ? TB : TA;
        const int cge = qq ? cgeB : cgeA;
        const bool tie = (T != 0u) && (cge > 256);
        int need = 1 << 30;
        if (tie) {
            int cgt = 0;
#pragma unroll
            for (int i = 0; i < 32; ++i) cgt += __builtin_popcountll(__builtin_amdgcn_ballot_w64((qq ? KB[i] : KA[i]) > T));
            need = 256 - cgt;
        }
        unsigned long long* wscr = (unsigned long long*)(lds + 16 * 264 * 2 + 16 * KMS * 4) + (w * 2 + qq) * 32;
        if (!tie) {
            const unsigned Tm = T > 1u ? T : 1u;
#pragma unroll
            for (int i = 0; i < 32; ++i) {
                const unsigned long long sel = __builtin_amdgcn_ballot_w64((qq ? KB[i] : KA[i]) >= Tm);
                if (lane == 0) wscr[i] = sel;
            }
        } else
#pragma unroll
        for (int i = 0; i < 32; ++i) {
            const unsigned k = qq ? KB[i] : KA[i];
            const unsigned long long gt = __builtin_amdgcn_ballot_w64(k > T);
            unsigned long long eq = __builtin_amdgcn_ballot_w64(k == T && k != 0u);
            if (tie) {
                if (need <= 0) eq = 0ull;
                else {
                    const int ce = __builtin_popcountll(eq);
                    if (ce > need) {
                        unsigned long long mm = eq, keep = 0ull;
                        for (int n = need; n > 0; --n) { const unsigned long long lb = mm & (0ull - mm); keep |= lb; mm ^= lb; }
                        eq = keep;
                    }
                    need -= __builtin_popcountll(eq);
                }
            }
            const unsigned long long sel = gt | eq;
            if (lane == 0) wscr[i] = sel;
        }
        const unsigned myword = ((const unsigned*)wscr)[lane];
        const int r32 = (qb16 & 1) * 16 + 2 * w + qq;
        if (lane <= qb32) maskw[((size_t)(b * 64 + qb32) * 64 + lane) * 32 + r32] = myword;
    }
    b = nb; qb16 = nq; have = hn;
  }
}

constexpr int A_STAGE = 20480;
DI void glds4(const unsigned* g, char* l) { __builtin_amdgcn_global_load_lds(g, (unsigned*)l, 4, 0, 0); }
struct AUnit { const bf16_t* q; const bf16_t* k; const bf16_t* kpe; const bf16_t* vt; const unsigned* mwb; const bf16_t* gate; bf16_t* out; int c; };
constexpr int AQ_OFF = 4 * A_STAGE;
template <int DQK, bool MASKED>
DI void attn_block(const AUnit& U, int ldq, float cscale, char* lds, bool pre, bool has_next, const AUnit& N) {
    constexpr int NKS = DQK / 16, CH = DQK / 8, QW = 32 * DQK * 2, QP = QW / 1024;
    const int tid = threadIdx.x, lane = tid & 63, w = __builtin_amdgcn_readfirstlane(tid >> 6), r = lane & 31, h = lane >> 5;
    const int c = U.c, qb32 = 8 * c + w, t0 = qb32 * 32, ntile = 4 * c + 4;
    const bf16_t* gate = U.gate; bf16_t* outp = U.out;
    const int lr8 = lane >> 3, lp8 = lane & 7, row8 = 8 * w + lr8, c8 = lp8 ^ ((row8 >> 1) & 7);
    const int row4 = 16 * (w & 3) + (lane >> 2), c4 = (lane & 3) ^ ((row4 >> 2) & 3);
    auto issue_u = [&](const AUnit& X, int j, int st) {
        char* sb = lds + st * A_STAGE;
        glds16(X.k + (size_t)row8 * 512 + c8 * 8 + (size_t)j * 64 * 512, sb + w * 1024);
        glds16(X.vt + (size_t)row8 * 2048 + c8 * 8 + j * 64, sb + 8192 + w * 1024);
        if (DQK == 96) glds16(X.kpe + (size_t)row4 * 32 + c4 * 8 + (size_t)j * 64 * 32, sb + 16384 + (w & 3) * 1024);
        if (MASKED) glds4(X.mwb + (size_t)(8 * X.c + w) * 64 * 32 + lane + j * 64, sb + 16384 + w * 256);
    };
    auto issue = [&](int j, int st) { issue_u(U, j, st); };
    auto issue_q = [&](const AUnit& X) {
        const int tx0 = (8 * X.c + w) * 32;
#pragma unroll
        for (int pz = 0; pz < QP; ++pz) {
            const int ci = pz * 64 + lane, row = ci / CH, cc = ci % CH;
            glds16(X.q + (size_t)(tx0 + row) * ldq + cc * 8, lds + AQ_OFF + w * QW + pz * 1024);
        }
    };
    bf16x8 qf[NKS];
    u32x2 gpre[2][4];
    f32x16 o0, o1;
#pragma unroll
    for (int i = 0; i < 16; ++i) { o0[i] = 0.f; o1[i] = 0.f; }
    float m = -30000.0f, l = 0.f;
    f32x16 o2;
#pragma unroll
    for (int i = 0; i < 16; ++i) o2[i] = 0.f;
    const bf16x8 ones = {16256, 16256, 16256, 16256, 16256, 16256, 16256, 16256};
    const int dlc = r - 4 * h;
    const unsigned cmask = dlc < 0 ? 0u : (dlc >= 31 ? 0xffffffffu : ((2u << dlc) - 1u));
    if (!pre) { RAW_BARRIER(); issue_q(U); issue(0, 0); issue(1, 1); }
    for (int jp = 0; jp < ntile; jp += 2) {
        asm volatile("s_waitcnt vmcnt(0)" ::: "memory");
        RAW_BARRIER();
        if (jp + 2 < ntile) { issue(jp + 2, (jp + 2) & 3); issue(jp + 3, (jp + 3) & 3); }
        else if (has_next) { issue_u(N, 0, 0); issue_u(N, 1, 1); issue_q(N); }
        if (jp == 0) {
#pragma unroll
            for (int ks = 0; ks < NKS; ++ks) qf[ks] = *(const bf16x8*)(lds + AQ_OFF + w * QW + ((r * CH + 2 * ks + h) << 4));
            const bf16_t* gp = gate + (size_t)(t0 + r) * 1024;
#pragma unroll
            for (int db = 0; db < 2; ++db)
#pragma unroll
                for (int g = 0; g < 4; ++g) gpre[db][g] = *(const u32x2*)(gp + 32 * db + 8 * g + 4 * h);
        }
#pragma unroll 1
      for (int j = jp; j < jp + 2; ++j) {
        const char* sb = lds + (j & 3) * A_STAGE;
        if (2 * j <= qb32) {
            f32x16 s0, s1;
#pragma unroll
            for (int i = 0; i < 16; ++i) { s0[i] = 0.f; s1[i] = 0.f; }
            const int kr0 = r, kr1 = 32 + r;
#pragma unroll
            for (int ks = 0; ks < NKS; ++ks) {
                bf16x8 kf0, kf1;
                if (ks < 4) {
                    kf0 = *(const bf16x8*)(sb + kr0 * 128 + (((2 * ks + h) ^ ((kr0 >> 1) & 7)) << 4));
                    kf1 = *(const bf16x8*)(sb + kr1 * 128 + (((2 * ks + h) ^ ((kr1 >> 1) & 7)) << 4));
                } else {
                    kf0 = *(const bf16x8*)(sb + 16384 + kr0 * 64 + (((2 * (ks - 4) + h) ^ ((kr0 >> 2) & 3)) << 4));
                    kf1 = *(const bf16x8*)(sb + 16384 + kr1 * 64 + (((2 * (ks - 4) + h) ^ ((kr1 >> 2) & 3)) << 4));
                }
                s0 = MFMA32(kf0, qf[ks], s0);
                s1 = MFMA32(kf1, qf[ks], s1);
            }
            float mx = -30000.0f;
            const bool need_mask = MASKED || (2 * j + 1 >= qb32);
            if (need_mask) {
                unsigned mb0 = 0xffffffffu, mb1 = (2 * j + 1 <= qb32) ? 0xffffffffu : 0u;
                if (MASKED) {
                    mb0 = *(const unsigned*)(sb + 16384 + w * 256 + r * 4) >> (4 * h);
                    const unsigned w1 = *(const unsigned*)(sb + 16384 + w * 256 + (32 + r) * 4) >> (4 * h);
                    mb1 = (2 * j + 1 <= qb32) ? w1 : 0u;
                }
                if (2 * j == qb32) mb0 &= cmask;
                if (2 * j + 1 == qb32) mb1 &= cmask;
#pragma unroll
                for (int i = 0; i < 16; ++i) {
                    const int ci = (i & 3) + 8 * (i >> 2);
                    const unsigned t0m = (unsigned)(((int)(mb0 << (31 - ci))) >> 31), t1m = (unsigned)(((int)(mb1 << (31 - ci))) >> 31);
                    s0[i] = __uint_as_float((t0m & __float_as_uint(s0[i])) | (~t0m & 0xc6ea6000u));
                    s1[i] = __uint_as_float((t1m & __float_as_uint(s1[i])) | (~t1m & 0xc6ea6000u));
                }
            }
            {
                float mxa = mx, mxb = mx;
#pragma unroll
                for (int i = 0; i < 16; i += 2) {
                    asm("v_max3_f32 %0, %1, %2, %3" : "=v"(mxa) : "v"(mxa), "v"(s0[i]), "v"(s1[i]));
                    asm("v_max3_f32 %0, %1, %2, %3" : "=v"(mxb) : "v"(mxb), "v"(s0[i + 1]), "v"(s1[i + 1]));
                }
                asm("v_max_f32 %0, %1, %2" : "=v"(mx) : "v"(mxa), "v"(mxb));
            }
            mx = xor32_max(mx);
            const float mnw = fmaxf(m, mx);
            const float al = __builtin_amdgcn_exp2f((m - mnw) * cscale);
            const float nmc = -mnw * cscale;
#pragma unroll
            for (int i = 0; i < 16; ++i) {
                s0[i] = __builtin_amdgcn_exp2f(fmaf(s0[i], cscale, nmc)); s1[i] = __builtin_amdgcn_exp2f(fmaf(s1[i], cscale, nmc));
            }
            if (__builtin_amdgcn_ballot_w64(mnw > m) != 0) {
#pragma unroll
                for (int i = 0; i < 16; ++i) { o0[i] *= al; o1[i] *= al; }
                o2[0] *= al;
            }
            m = mnw;
            u32x4 pk[4];
#pragma unroll
            for (int q = 0; q < 4; ++q) {
                pk[0][q] = cvt_pk_bf16(s0[2 * q], s0[2 * q + 1]); pk[1][q] = cvt_pk_bf16(s0[8 + 2 * q], s0[8 + 2 * q + 1]);
                pk[2][q] = cvt_pk_bf16(s1[2 * q], s1[2 * q + 1]); pk[3][q] = cvt_pk_bf16(s1[8 + 2 * q], s1[8 + 2 * q + 1]);
            }
#pragma unroll
            for (int kk = 0; kk < 4; ++kk) {
                const bf16x8 pb = __builtin_bit_cast(bf16x8, pk[kk]);
                bf16x8 vfr[1][2];
#pragma unroll
                for (int db = 0; db < 2; ++db) { const int d = 32 * db + r; vfr[0][db] = *(const bf16x8*)(sb + 8192 + d * 128 + (((2 * kk + h) ^ ((d >> 1) & 7)) << 4)); }
                o0 = MFMA32(vfr[0][0], pb, o0);
                o1 = MFMA32(vfr[0][1], pb, o1);
                o2 = MFMA32(ones, pb, o2);
            }
        }
      }
    }
    l = o2[0];
    const float inv = 1.f / l;
    bf16_t* op = outp + (size_t)(t0 + r) * 1024;
#pragma unroll
    for (int db = 0; db < 2; ++db) {
#pragma unroll
        for (int g = 0; g < 4; ++g) {
            const int d = 32 * db + 8 * g + 4 * h;
            const u32x2 gv = gpre[db][g];
            float v0, v1, v2, v3;
            if (db == 0) { v0 = o0[4 * g]; v1 = o0[4 * g + 1]; v2 = o0[4 * g + 2]; v3 = o0[4 * g + 3]; }
            else { v0 = o1[4 * g]; v1 = o1[4 * g + 1]; v2 = o1[4 * g + 2]; v3 = o1[4 * g + 3]; }
            v0 *= inv * __uint_as_float(gv[0] << 16); v1 *= inv * __uint_as_float(gv[0] & 0xffff0000u);
            v2 *= inv * __uint_as_float(gv[1] << 16); v3 *= inv * __uint_as_float(gv[1] & 0xffff0000u);
            u32x2 ov; ov[0] = cvt_pk_bf16(v0, v1); ov[1] = cvt_pk_bf16(v2, v3);
            *(u32x2*)(op + d) = ov;
        }
    }
}

__global__ void __launch_bounds__(512) mega(Params p) {
    cg::grid_group grid = cg::this_grid();
    extern __shared__ __attribute__((aligned(16))) char lds[];
    char* ws = p.ws;
    const int tid = threadIdx.x, G = gridDim.x, bid = blockIdx.x;

#ifndef SKIP_P0
    for (int rep = 0; rep < REP0; ++rep) {
        if (bid == 0 && tid == 0) __hip_atomic_store((unsigned*)(ws + OFF_BAR), 0u, __ATOMIC_RELAXED, __HIP_MEMORY_SCOPE_AGENT);
        float* tile = (float*)lds;
        auto do_transposes = [&]() {
            transpose_convert(p.w_in, DIN, 1024, NPAD, (bf16_t*)(ws + OFF_WINT), nullptr, MapIn{}, tile);
            transpose_convert(p.w_uq, 768, 256, 1024, (bf16_t*)(ws + OFF_WUQT), p.qg, MapUq{}, tile);
            transpose_convert(p.w_ukv, 1024, 128, 1024, (bf16_t*)(ws + OFF_WUKVT), p.kvg, MapId{}, tile);
            transpose_convert(p.w_out, 1024, 1024, 1024, (bf16_t*)(ws + OFF_WOUTT), nullptr, MapId{}, tile);
        };
        auto do_xconv = [&]() {
            const size_t n4 = (size_t)NTOK * DM / 4;
            u32x2* xb = (u32x2*)(ws + OFF_XB);
            const size_t stride = (size_t)G * 512;
            for (size_t i0 = (size_t)bid * 512 + tid; i0 < n4; i0 += stride * 16) {
                float4 v[16];
#pragma unroll
                for (int u = 0; u < 16; ++u) { const size_t i = i0 + u * stride; if (i < n4) v[u] = nt_load4(p.x + 4 * i); }
#pragma unroll
                for (int u = 0; u < 16; ++u) {
                    const size_t i = i0 + u * stride;
                    if (i < n4) { u32x2 o; o[0] = cvt_pk_bf16(v[u].x, v[u].y); o[1] = cvt_pk_bf16(v[u].z, v[u].w); xb[i] = o; }
                }
            }
        };
        auto do_rope = [&]() {
            float2* rope = (float2*)(ws + OFF_ROPE);
            for (int i = bid * 512 + tid; i < NTOK * 32; i += G * 512) {
                const int tok = i >> 5, f = i & 31;
                const float inv = powf(10000.0f, -(float)f / 32.0f);
                const float ang = (float)p.pos[tok] * inv;
                float sn, cs; sincosf(ang, &sn, &cs);
                rope[i] = make_float2(cs, sn);
            }
        };
        if ((bid >> 3) & 1) { do_xconv(); do_rope(); do_transposes(); }
        else { do_transposes(); do_xconv(); do_rope(); }
    }
#endif
    grid.sync();

    float* rs_s = (float*)(lds + 3 * G_STAGE);
    const int xcd = bid & 7, li = bid >> 3, nxb = G >> 3;
#ifndef SKIP_P1
    for (int rep = 0; rep < REP1; ++rep) {
        for (int t = li; t < 192; t += nxb) {
            const int mg = t / 52, rem = t % 52, nt4 = rem >> 2, mi = rem & 3;
            const int mt = xcd * 16 + mg * 4 + mi;
            EpiIn e; e.ws = ws; e.nt = 0;
            gemm256x256((const bf16_t*)(ws + OFF_XB), 1024, (const bf16_t*)(ws + OFF_WINT), 1024, 1024, mt * 256, nt4 * 256, lds, e);
        }
        if (li < 32) {
            const int t = 192 + (li >> 1), mg = t / 52, rem = t % 52, nt4 = rem >> 2, mi = rem & 3;
            const int mt = xcd * 16 + mg * 4 + mi, nt2 = nt4 * 2 + (li & 1);
            EpiIn e; e.ws = ws; e.nt = nt2;
            gemm256((const bf16_t*)(ws + OFF_XB), 1024, (const bf16_t*)(ws + OFF_WINT), 1024, 1024, mt * 256, nt2 * 128, lds, e);
        }
    }
#endif
    fast_grid_barrier((unsigned*)(ws + OFF_BAR), 1u * (unsigned)G);

    auto do_p2 = [&]() {
    for (int rep = 0; rep < REP2; ++rep)
    for (int t = bid; t < 256; t += G) {
        const int kind = t >> 7, mt = t & 127;
        if (kind == 0) {
            row_rms((const bf16_t*)(ws + OFF_CQ), 256, mt * 256, rs_s);
            for (int nt2 = 0; nt2 < 8; ++nt2) {
                EpiUq e{ws, nt2, rs_s, mt * 256};
                gemm256((const bf16_t*)(ws + OFF_CQ), 256, (const bf16_t*)(ws + OFF_WUQT), 256, 256, mt * 256, nt2 * 128, lds, e);
            }
        } else {
            row_rms((const bf16_t*)(ws + OFF_CKV), 128, mt * 256, rs_s);
            for (int nt2 = 0; nt2 < 8; ++nt2) {
                EpiUkv e{ws, nt2, rs_s, mt * 256};
                gemm256((const bf16_t*)(ws + OFF_CKV), 128, (const bf16_t*)(ws + OFF_WUKVT), 128, 128, mt * 256, nt2 * 128, lds, e);
            }
        }
    }
    };
    if (bid & 1) { indexer_stream(ws, lds, G, bid, REP3); do_p2(); }
    else { do_p2(); indexer_stream(ws, lds, G, bid, REP3); }
    fast_grid_barrier((unsigned*)(ws + OFF_BAR), 2u * (unsigned)G);

#ifndef SKIP_P4
    for (int rep = 0; rep < REP4; ++rep) {
        auto unit_of = [&](int rd, int& branch, AUnit& U) -> bool {
            int c, rest;
            if (G == 256) { if (rd >= 8) return false; rest = xcd * 32 + rd * 4 + (li >> 3); c = ((li & 7) + rd) & 7; }
            else { const int u = rd * G + bid; if (u >= 2048) return false; c = 7 - (u >> 8); rest = u & 255; }
            branch = rest >> 7;
            const int b = (rest >> 3) & 15, head = rest & 7;
            const size_t tokb = (size_t)b * SEQ;
            U.c = c;
            if (branch == 0) {
                U.q = (const bf16_t*)(ws + OFF_QA) + tokb * 512 + head * 64; U.k = (const bf16_t*)(ws + OFF_KA) + tokb * 512 + head * 64; U.kpe = nullptr;
                U.vt = (const bf16_t*)(ws + OFF_VTA) + (size_t)(b * 8 + head) * 64 * 2048; U.mwb = (const unsigned*)(ws + OFF_MASK) + (size_t)(b * 64) * 64 * 32;
                U.gate = (const bf16_t*)(ws + OFF_GATE) + tokb * 1024 + head * 64; U.out = (bf16_t*)(ws + OFF_XB) + tokb * 1024 + head * 64;
            } else {
                U.q = (const bf16_t*)(ws + OFF_QB) + tokb * 768 + head * 96; U.k = (const bf16_t*)(ws + OFF_KB) + tokb * 512 + head * 64; U.kpe = (const bf16_t*)(ws + OFF_KPE) + tokb * 32;
                U.vt = (const bf16_t*)(ws + OFF_VTB) + (size_t)(b * 8 + head) * 64 * 2048; U.mwb = nullptr;
                U.gate = (const bf16_t*)(ws + OFF_GATE) + tokb * 1024 + 512 + head * 64; U.out = (bf16_t*)(ws + OFF_XB) + tokb * 1024 + 512 + head * 64;
            }
            return true;
        };
        AUnit U, N; int br = 0, brn = 0, rd = 0;
        while (unit_of(rd, br, U)) {
            bool pre = false;
            if (br == 0) {
                for (;;) {
                    const bool chain = unit_of(rd + 1, brn, N) && brn == 0;
                    attn_block<64, true>(U, 512, 0.125f * 1.44269504089f, lds, pre, chain, N);
                    ++rd; if (!chain) break; pre = true; U = N;
                }
            } else {
                for (;;) {
                    const bool chain = unit_of(rd + 1, brn, N) && brn == 1;
                    attn_block<96, false>(U, 768, 0.10206207262f * 1.44269504089f, lds, pre, chain, N);
                    ++rd; if (!chain) break; pre = true; U = N;
                }
            }
        }
    }
#endif
    fast_grid_barrier((unsigned*)(ws + OFF_BAR), 3u * (unsigned)G);

#ifndef SKIP_P5
    for (int rep = 0; rep < REP5; ++rep)
    for (int t = li; t < 128; t += nxb) {
        const int mg = t >> 5, rem = t & 31, nt2 = rem >> 2, mi = rem & 3;
        const int mt = xcd * 16 + mg * 4 + mi;
        EpiOut e; e.x = p.x; e.out = p.out; e.n0 = nt2 * 128;
        gemm256((const bf16_t*)(ws + OFF_XB), 1024, (const bf16_t*)(ws + OFF_WOUTT), 1024, 1024, mt * 256, nt2 * 128, lds, e);
    }
#endif
    fast_grid_barrier((unsigned*)(ws + OFF_BAR), 4u * (unsigned)G);

    {
        const int lane = tid & 63, w = __builtin_amdgcn_readfirstlane(tid >> 6);
        const int NWv = G * 8, gw = bid * 8 + w;
        float4 gg[4], bb[4];
#pragma unroll
        for (int i = 0; i < 4; ++i) { gg[i] = ((const float4*)p.ln_g)[lane + 64 * i]; bb[i] = ((const float4*)p.ln_b)[lane + 64 * i]; }
        for (int row0 = gw * 4; row0 < NTOK; row0 += NWv * 4) {
            float4 v[4][4];
#pragma unroll
            for (int rr = 0; rr < 4; ++rr)
#pragma unroll
                for (int i = 0; i < 4; ++i) v[rr][i] = nt_load4(p.out + (size_t)(row0 + rr) * 1024 + 4 * (lane + 64 * i));
            float s[4], q[4];
#pragma unroll
            for (int rr = 0; rr < 4; ++rr) {
                s[rr] = 0.f;
#pragma unroll
                for (int i = 0; i < 4; ++i) s[rr] += v[rr][i].x + v[rr][i].y + v[rr][i].z + v[rr][i].w;
            }
#pragma unroll
            for (int off = 32; off >= 1; off >>= 1)
#pragma unroll
                for (int rr = 0; rr < 4; ++rr) s[rr] += __shfl_xor(s[rr], off);
#pragma unroll
            for (int rr = 0; rr < 4; ++rr) {
                const float mu = s[rr] * (1.f / 1024.f);
                q[rr] = 0.f;
#pragma unroll
                for (int i = 0; i < 4; ++i) {
                    v[rr][i].x -= mu; v[rr][i].y -= mu; v[rr][i].z -= mu; v[rr][i].w -= mu;
                    q[rr] += v[rr][i].x * v[rr][i].x + v[rr][i].y * v[rr][i].y + v[rr][i].z * v[rr][i].z + v[rr][i].w * v[rr][i].w;
                }
            }
#pragma unroll
            for (int off = 32; off >= 1; off >>= 1)
#pragma unroll
                for (int rr = 0; rr < 4; ++rr) q[rr] += __shfl_xor(q[rr], off);
#pragma unroll
            for (int rr = 0; rr < 4; ++rr) {
                const float rstd = __builtin_amdgcn_rsqf(q[rr] * (1.f / 1024.f) + 1e-5f);
#pragma unroll
                for (int i = 0; i < 4; ++i) {
                    float4 y; y.x = v[rr][i].x * rstd * gg[i].x + bb[i].x; y.y = v[rr][i].y * rstd * gg[i].y + bb[i].y;
                    y.z = v[rr][i].z * rstd * gg[i].z + bb[i].z; y.w = v[rr][i].w * rstd * gg[i].w + bb[i].w;
                    nt_store4(p.out + (size_t)(row0 + rr) * 1024 + 4 * (lane + 64 * i), y);
                }
            }
        }
    }
}

extern "C" void kernel_launch(void* const* d_in, const int* in_sizes, int n_in, void* d_out, int out_size, void* d_ws, size_t ws_size, hipStream_t stream) {
    static int grid_blocks = 0;
    if (!grid_blocks) {
        int dev = 0, cus = 0, per_cu = 0;
        hipGetDevice(&dev);
        hipDeviceGetAttribute(&cus, hipDeviceAttributeMultiprocessorCount, dev);
        if (hipFuncSetAttribute((const void*)mega, hipFuncAttributeMaxDynamicSharedMemorySize, LDS_BYTES) != hipSuccess) fprintf(stderr, "kernel_launch: hipFuncSetAttribute failed\n");
        if (hipOccupancyMaxActiveBlocksPerMultiprocessor(&per_cu, mega, 512, LDS_BYTES) != hipSuccess || per_cu < 1) per_cu = 1;
        if (per_cu > 1) per_cu = 1;
        grid_blocks = cus * per_cu;
        if (ws_size < WS_END) fprintf(stderr, "kernel_launch: workspace too small: %zu < %zu\n", ws_size, (size_t)WS_END);
    }
    Params p{};
    p.x = (const float*)d_in[0]; p.pos = (const int*)d_in[1]; p.w_in = (const float*)d_in[2]; p.qg = (const float*)d_in[3];
    p.w_uq = (const float*)d_in[4]; p.kvg = (const float*)d_in[5]; p.w_ukv = (const float*)d_in[6]; p.w_out = (const float*)d_in[7];
    p.ln_g = (const float*)d_in[8]; p.ln_b = (const float*)d_in[9]; p.out = (float*)d_out; p.ws = (char*)d_ws;
    void* args[] = {&p};
    hipError_t e = hipLaunchCooperativeKernel((const void*)mega, dim3(grid_blocks), dim3(512), args, LDS_BYTES, stream);
    if (e != hipSuccess) fprintf(stderr, "cooperative launch failed: %s (grid %d)\n", hipGetErrorString(e), grid_blocks);
}
```

```cpp
#include <hip/hip_runtime.h>
#include <hip/hip_cooperative_groups.h>
#include <cstdio>
#include <cstdint>
namespace cg = cooperative_groups;
#ifndef REP0
#define REP0 1
#endif
#ifndef REP1
#define REP1 1
#endif
#ifndef REP2
#define REP2 1
#endif
#ifndef REP3
#define REP3 1
#endif
#ifndef REP4
#define REP4 1
#endif
#ifndef REP5
#define REP5 1
#endif
#ifndef REP6
#define REP6 1
#endif

#define DI __device__ __forceinline__
typedef unsigned short bf16_t;
typedef short bf16x8 __attribute__((ext_vector_type(8)));
typedef short s16x4 __attribute__((ext_vector_type(4)));
typedef float f32x16 __attribute__((ext_vector_type(16)));
typedef unsigned u32x4 __attribute__((ext_vector_type(4)));
typedef unsigned u32x2 __attribute__((ext_vector_type(2)));
typedef float f32x4v __attribute__((ext_vector_type(4)));
DI float4 nt_load4(const float* p) { const f32x4v v = __builtin_nontemporal_load((const f32x4v*)p); return make_float4(v[0], v[1], v[2], v[3]); }
DI void nt_store4(float* p, float4 y) { f32x4v v = {y.x, y.y, y.z, y.w}; __builtin_nontemporal_store(v, (f32x4v*)p); }

constexpr int NB = 16, SEQ = 2048, NTOK = NB * SEQ, DM = 1024, DIN = 3272, NPAD = 3328;
constexpr float ALPHA = 1.189207115002721f;

constexpr size_t al256(size_t x) { return (x + 255) & ~(size_t)255; }
constexpr size_t OFF_WINT = 0;
constexpr size_t OFF_WUQT = OFF_WINT + al256((size_t)NPAD * 1024 * 2);
constexpr size_t OFF_WUKVT = OFF_WUQT + al256((size_t)1024 * 256 * 2);
constexpr size_t OFF_WOUTT = OFF_WUKVT + al256((size_t)1024 * 128 * 2);
constexpr size_t OFF_XB = OFF_WOUTT + al256((size_t)1024 * 1024 * 2);
constexpr size_t OFF_ROPE = OFF_XB + al256((size_t)NTOK * 1024 * 2);
constexpr size_t OFF_QA = OFF_ROPE + al256((size_t)NTOK * 32 * 8);
constexpr size_t OFF_KA = OFF_QA + al256((size_t)NTOK * 512 * 2);
constexpr size_t OFF_VTA = OFF_KA + al256((size_t)NTOK * 512 * 2);
constexpr size_t OFF_GATE = OFF_VTA + al256((size_t)NTOK * 512 * 2);
constexpr size_t OFF_IQ = OFF_GATE + al256((size_t)NTOK * 1024 * 2);
constexpr size_t OFF_IK = OFF_IQ + al256((size_t)NTOK * 256 * 2);
constexpr size_t OFF_IW = OFF_IK + al256((size_t)NTOK * 32 * 2);
constexpr size_t OFF_CQ = OFF_IW + al256((size_t)NTOK * 8 * 4);
constexpr size_t OFF_CKV = OFF_CQ + al256((size_t)NTOK * 256 * 2);
constexpr size_t OFF_KPE = OFF_CKV + al256((size_t)NTOK * 128 * 2);
constexpr size_t OFF_QB = OFF_KPE + al256((size_t)NTOK * 32 * 2);
constexpr size_t OFF_KB = OFF_QB + al256((size_t)NTOK * 768 * 2);
constexpr size_t OFF_VTB = OFF_KB + al256((size_t)NTOK * 512 * 2);
constexpr size_t OFF_MASK = OFF_VTB + al256((size_t)NTOK * 512 * 2);
constexpr size_t OFF_BAR = OFF_MASK + al256((size_t)NB * 64 * 64 * 32 * 4);
constexpr size_t WS_END = OFF_BAR + 256;

struct Params {
    const float* x; const int* pos; const float* w_in; const float* qg; const float* w_uq; const float* kvg;
    const float* w_ukv; const float* w_out; const float* ln_g; const float* ln_b; float* out; char* ws;
};

DI void lds_barrier() { __builtin_amdgcn_fence(__ATOMIC_RELEASE, "workgroup", "local"); __builtin_amdgcn_s_barrier(); __builtin_amdgcn_fence(__ATOMIC_ACQUIRE, "workgroup", "local"); }
DI void fast_grid_barrier(unsigned* ctr, unsigned target) {
    asm volatile("s_waitcnt vmcnt(0)" ::: "memory");
    __syncthreads();
    if (threadIdx.x == 0) {
        __builtin_amdgcn_fence(__ATOMIC_RELEASE, "agent");
        asm volatile("s_waitcnt vmcnt(0)" ::: "memory");
        __hip_atomic_fetch_add(ctr, 1u, __ATOMIC_RELAXED, __HIP_MEMORY_SCOPE_AGENT);
        unsigned spins = 0;
        while (__hip_atomic_load(ctr, __ATOMIC_RELAXED, __HIP_MEMORY_SCOPE_AGENT) < target && ++spins < (1u << 22)) __builtin_amdgcn_s_sleep(1);
        __builtin_amdgcn_fence(__ATOMIC_ACQUIRE, "agent");
        asm volatile("s_waitcnt vmcnt(0)" ::: "memory");
    }
    __syncthreads();
}
DI int crow(int i, int h) { return (i & 3) + 8 * (i >> 2) + 4 * h; }
typedef float f32x2v __attribute__((ext_vector_type(2)));
typedef __bf16 bf16x2v __attribute__((ext_vector_type(2)));
DI unsigned cvt_pk_bf16(float lo, float hi) { const f32x2v v = {lo, hi}; const bf16x2v b = __builtin_convertvector(v, bf16x2v); return __builtin_bit_cast(unsigned, b); }
DI bf16_t f2bf(float x) { return (bf16_t)(cvt_pk_bf16(x, 0.f) & 0xffffu); }
DI float bf2f(unsigned short v) { return __uint_as_float(((unsigned)v) << 16); }
DI float silu(float x) { return x * __builtin_amdgcn_rcpf(1.f + __builtin_amdgcn_exp2f(-1.44269504089f * x)); }
DI float xor32_max(float x) { auto t = __builtin_amdgcn_permlane32_swap(__float_as_uint(x), __float_as_uint(x), false, false); return fmaxf(__uint_as_float(t[0]), __uint_as_float(t[1])); }
DI float xor32_sum(float x) { auto t = __builtin_amdgcn_permlane32_swap(__float_as_uint(x), __float_as_uint(x), false, false); return __uint_as_float(t[0]) + __uint_as_float(t[1]); }
DI int xrow16_sum_i(int x) {
    auto s = __builtin_amdgcn_permlane16_swap((unsigned)x, (unsigned)x, false, false);
    x = (int)(s[0] + s[1]);
    auto t = __builtin_amdgcn_permlane32_swap((unsigned)x, (unsigned)x, false, false);
    return (int)(t[0] + t[1]);
}
DI unsigned xrow16_or(unsigned x) {
    auto s = __builtin_amdgcn_permlane16_swap(x, x, false, false);
    x = s[0] | s[1];
    auto t = __builtin_amdgcn_permlane32_swap(x, x, false, false);
    return t[0] | t[1];
}
template <int CTRL> DI int dpp_i(int x) { return __builtin_amdgcn_mov_dpp(x, CTRL, 0xf, 0xf, true); }
DI int wave_sum_i(int x) {
    x += dpp_i<0xB1>(x);
    x += dpp_i<0x4E>(x);
    x += dpp_i<0x141>(x);
    x += dpp_i<0x140>(x);
    return xrow16_sum_i(x);
}
#define CNT4(c0, c1, c2, c3, k0, k1, k2, k3, cand) do { unsigned long long t0_, t1_, t2_, t3_; \
    asm("v_cmp_le_u32_e64 %4, %12, %8\n\tv_cmp_le_u32_e64 %5, %12, %9\n\tv_cmp_le_u32_e64 %6, %12, %10\n\tv_cmp_le_u32_e64 %7, %12, %11\n\t" \
        "v_addc_co_u32_e64 %0, %4, %0, 0, %4\n\tv_addc_co_u32_e64 %1, %5, %1, 0, %5\n\tv_addc_co_u32_e64 %2, %6, %2, 0, %6\n\tv_addc_co_u32_e64 %3, %7, %3, 0, %7" \
        : "+v"(c0), "+v"(c1), "+v"(c2), "+v"(c3), "=&s"(t0_), "=&s"(t1_), "=&s"(t2_), "=&s"(t3_) \
        : "v"(k0), "v"(k1), "v"(k2), "v"(k3), "s"(cand)); } while (0)
#define MFMA32(a, b, c) __builtin_amdgcn_mfma_f32_32x32x16_bf16((a), (b), (c), 0, 0, 0)

struct MapIn { DI int operator()(int p) const {
    if (p < 2048) return p;
    if (p < 2304) { int q = p - 2048, gq = q >> 6, c = q & 63, half = c >> 5, hh = (c & 31) >> 4, i = c & 15; return 2048 + (2 * gq + hh) * 32 + half * 16 + i; }
    if (p < 2368) { int c = p - 2304, half = c >> 5, sub = (c & 31) >> 4, i = c & 15; return (sub ? 2728 : 2304) + half * 16 + i; }
    if (p < 2432) { int c = p - 2368; return c < 8 ? 2336 + c : -1; }
    if (p < 2688) return 2344 + (p - 2432);
    if (p < 2816) return 2600 + (p - 2688);
    return 2760 + (p - 2816);
} };
struct MapUq { DI int operator()(int p) const {
    int head = p >> 7, c = p & 127;
    if (c < 64) return head * 96 + c;
    int c2 = c - 64, half = c2 >> 5, i = c2 & 31;
    return i < 16 ? head * 96 + 64 + half * 16 + i : -1;
} };
struct MapId { DI int operator()(int p) const { return p; } };

template <class Map>
DI void transpose_convert(const float* __restrict__ src, int ldsrc, int K, int P, bf16_t* __restrict__ dst, const float* __restrict__ kscale, Map map, float* tile) {
    const int tid = threadIdx.x;
    const int tilesK = K >> 6, tilesP = P >> 6;
    for (int t = blockIdx.x; t < tilesK * tilesP; t += gridDim.x) {
        const int tk = t % tilesK, tp = t / tilesK;
        const int c = tid & 63, r0 = tid >> 6;
        const int oc = map(tp * 64 + c);
        __syncthreads();
#pragma unroll
        for (int i = 0; i < 8; ++i) {
            const int r = r0 + 8 * i, k = tk * 64 + r;
            float v = oc >= 0 ? src[(size_t)k * ldsrc + oc] : 0.f;
            if (kscale) v *= kscale[k];
            tile[r * 65 + c] = v;
        }
        __syncthreads();
        const int prow = tid >> 3, kseg = (tid & 7) * 8;
        u32x4 o;
#pragma unroll
        for (int j = 0; j < 4; ++j) o[j] = cvt_pk_bf16(tile[(kseg + 2 * j) * 65 + prow], tile[(kseg + 2 * j + 1) * 65 + prow]);
        *(u32x4*)(dst + (size_t)(tp * 64 + prow) * K + tk * 64 + kseg) = o;
    }
}

constexpr int G_STAGE = 49152;
constexpr int LDS_BYTES = 3 * G_STAGE + 2048;
#define RAW_BARRIER() do { asm volatile("s_waitcnt lgkmcnt(0)" ::: "memory"); __builtin_amdgcn_s_barrier(); } while (0)
DI void glds16(const bf16_t* g, char* l) { __builtin_amdgcn_global_load_lds((const unsigned*)g, (unsigned*)l, 16, 0, 0); }
template <class Epi>
DI void gemm256(const bf16_t* __restrict__ A, int lda, const bf16_t* __restrict__ Bt, int ldb, int K, int m0, int n0, char* lds, Epi epi) {
    const int tid = threadIdx.x, lane = tid & 63, w = __builtin_amdgcn_readfirstlane(tid >> 6), wm = w >> 1, wn = w & 1, r = lane & 31, h = lane >> 5;
    const int lr = lane >> 3, lp = lane & 7;
    auto issue = [&](int kt, int st) {
        char* sb = lds + st * G_STAGE;
#pragma unroll
        for (int i = 0; i < 4; ++i) {
            const int rowb = (w * 4 + i) * 8, row = rowb + lr, c = lp ^ ((row >> 1) & 7);
            glds16(A + (size_t)(m0 + row) * lda + kt * 64 + c * 8, sb + rowb * 128);
        }
#pragma unroll
        for (int i = 0; i < 2; ++i) {
            const int rowb = (w * 2 + i) * 8, row = rowb + lr, c = lp ^ ((row >> 1) & 7);
            glds16(Bt + (size_t)(n0 + row) * ldb + kt * 64 + c * 8, sb + 32768 + rowb * 128);
        }
    };
    f32x16 acc[2][2];
#pragma unroll
    for (int a = 0; a < 2; ++a)
#pragma unroll
        for (int b = 0; b < 2; ++b)
#pragma unroll
            for (int i = 0; i < 16; ++i) acc[a][b][i] = 0.f;
    const int nk = K >> 6;
    epi.prefetch(m0 + 64 * wm, wn, r, h);
    RAW_BARRIER();
    issue(0, 0);
    if (nk > 1) issue(1, 1);
#pragma unroll 1
    for (int kt = 0; kt < nk; ++kt) {
        if (kt + 1 < nk) asm volatile("s_waitcnt vmcnt(6)" ::: "memory"); else asm volatile("s_waitcnt vmcnt(0)" ::: "memory");
        RAW_BARRIER();
        if (kt + 2 < nk) issue(kt + 2, (kt + 2) % 3);
        const char* sa = lds + (kt % 3) * G_STAGE;
        const char* sbb = sa + 32768;
#pragma unroll
        for (int ks = 0; ks < 4; ++ks) {
            bf16x8 af[2], bfr[2];
#pragma unroll
            for (int mi = 0; mi < 2; ++mi) { const int row = 64 * wm + 32 * mi + r; af[mi] = *(const bf16x8*)(sa + row * 128 + (((2 * ks + h) ^ ((row >> 1) & 7)) << 4)); }
#pragma unroll
            for (int j = 0; j < 2; ++j) { const int row = 64 * wn + 32 * j + r; bfr[j] = *(const bf16x8*)(sbb + row * 128 + (((2 * ks + h) ^ ((row >> 1) & 7)) << 4)); }
#pragma unroll
            for (int mi = 0; mi < 2; ++mi)
#pragma unroll
                for (int j = 0; j < 2; ++j) acc[mi][j] = MFMA32(af[mi], bfr[j], acc[mi][j]);
        }
    }
    epi(acc[0][0], acc[0][1], m0 + 64 * wm, wn, r, h, 0);
    epi(acc[1][0], acc[1][1], m0 + 64 * wm + 32, wn, r, h, 1);
}

constexpr int G2_STAGE = 32768;
template <class Epi>
DI void gemm256x256(const bf16_t* __restrict__ A, int lda, const bf16_t* __restrict__ Bt, int ldb, int K, int m0, int n0, char* lds, Epi epi) {
    const int tid = threadIdx.x, lane = tid & 63, w = __builtin_amdgcn_readfirstlane(tid >> 6), wm = w >> 1, wn = w & 1, r = lane & 31, h = lane >> 5;
    const int lr = lane >> 2, lp = lane & 3;
    auto issue = [&](int kt, int st) {
        char* sb = lds + st * G2_STAGE;
#pragma unroll
        for (int i = 0; i < 2; ++i) {
            const int rowb = (w * 2 + i) * 16, row = rowb + lr, c = lp ^ ((row >> 2) & 3);
            glds16(A + (size_t)(m0 + row) * lda + kt * 32 + c * 8, sb + rowb * 64);
            glds16(Bt + (size_t)(n0 + row) * ldb + kt * 32 + c * 8, sb + 16384 + rowb * 64);
        }
    };
    f32x16 acc[2][4];
#pragma unroll
    for (int a = 0; a < 2; ++a)
#pragma unroll
        for (int b = 0; b < 4; ++b)
#pragma unroll
            for (int i = 0; i < 16; ++i) acc[a][b][i] = 0.f;
    const int nk = K >> 5;
    const int grp0 = (n0 >> 6) + 2 * wn;
    epi.prefetch_mi(m0 + 64 * wm, grp0, r, h, 0);
    RAW_BARRIER();
    issue(0, 0); issue(1, 1); issue(2, 2);
#pragma unroll 2
    for (int kt = 0; kt < nk; ++kt) {
        if (kt + 2 < nk) asm volatile("s_waitcnt vmcnt(8)" ::: "memory");
        else if (kt + 1 < nk) asm volatile("s_waitcnt vmcnt(4)" ::: "memory");
        else asm volatile("s_waitcnt vmcnt(0)" ::: "memory");
        RAW_BARRIER();
        if (kt + 3 < nk) issue(kt + 3, (kt + 3) & 3);
        const char* sa = lds + (kt & 3) * G2_STAGE;
        const char* sbb = sa + 16384;
#pragma unroll
        for (int ks = 0; ks < 2; ++ks) {
            bf16x8 af[2], bfr[4];
#pragma unroll
            for (int mi = 0; mi < 2; ++mi) { const int row = 64 * wm + 32 * mi + r; af[mi] = *(const bf16x8*)(sa + row * 64 + (((2 * ks + h) ^ ((row >> 2) & 3)) << 4)); }
#pragma unroll
            for (int j = 0; j < 4; ++j) { const int row = 128 * wn + 32 * j + r; bfr[j] = *(const bf16x8*)(sbb + row * 64 + (((2 * ks + h) ^ ((row >> 2) & 3)) << 4)); }
#pragma unroll
            for (int mi = 0; mi < 2; ++mi)
#pragma unroll
                for (int j = 0; j < 4; ++j) acc[mi][j] = MFMA32(af[mi], bfr[j], acc[mi][j]);
        }
    }
    epi(acc[0][0], acc[0][1], m0 + 64 * wm, grp0, r, h, 0);
    epi.prefetch_mi(m0 + 64 * wm, grp0, r, h, 1);
    epi(acc[0][2], acc[0][3], m0 + 64 * wm, grp0 + 1, r, h, 0);
    epi(acc[1][0], acc[1][1], m0 + 64 * wm + 32, grp0, r, h, 1);
    epi(acc[1][2], acc[1][3], m0 + 64 * wm + 32, grp0 + 1, r, h, 1);
}

DI void store_vt4(bf16_t* vt, int head, int d, int row, float a, float b, float c, float e) {
    const int bb = row >> 11, s0_ = row & 2047, s = (s0_ & ~12) | ((s0_ & 4) << 1) | ((s0_ & 8) >> 1);
    u32x2 v; v[0] = cvt_pk_bf16(a, b); v[1] = cvt_pk_bf16(c, e);
    *(u32x2*)(vt + (unsigned)(((bb * 8 + head) * 64 + d) * 2048 + s)) = v;
}

struct EpiIn {
    char* ws; int nt; float2 pcs[2][16];
    DI void prefetch_mi(int row0, int wn, int r, int h, int mi) {
        const int grp = nt * 2 + wn;
        const float2* rope = (const float2*)(ws + OFF_ROPE);
        if (grp < 16 || (grp >= 32 && grp < 37)) {
            const int idx = grp < 16 ? r : 2 * (r & 15);
#pragma unroll
            for (int i = 0; i < 16; ++i) {
                const float2 v = rope[(unsigned)(row0 + 32 * mi + crow(i, h)) * 32u + idx];
                if (mi) pcs[1][i] = v; else pcs[0][i] = v;
            }
        }
    }
    DI void prefetch(int row0, int wn, int r, int h) { prefetch_mi(row0, wn, r, h, 0); prefetch_mi(row0, wn, r, h, 1); }
    DI void operator()(const f32x16& a0, const f32x16& a1, int row0, int wn, int r, int h, int mi) {
        const int grp = nt * 2 + wn;
        if (grp < 16) {
            bf16_t* dst = (bf16_t*)(ws + (grp < 8 ? OFF_QA : OFF_KA));
            const int head = grp & 7;
#pragma unroll
            for (int i = 0; i < 16; ++i) {
                const int row = row0 + crow(i, h);
                const float2 cs = mi ? pcs[1][i] : pcs[0][i];
                const float x1 = a0[i], x2 = a1[i];
                dst[(unsigned)row * 512u + head * 64 + r] = f2bf(x1 * cs.x - x2 * cs.y);
                dst[(unsigned)row * 512u + head * 64 + 32 + r] = f2bf(x1 * cs.y + x2 * cs.x);
            }
        } else if (grp < 24) {
            bf16_t* vt = (bf16_t*)(ws + OFF_VTA);
            const int head = grp - 16;
#pragma unroll
            for (int g = 0; g < 4; ++g) {
                const int row = row0 + 8 * g + 4 * h;
                store_vt4(vt, head, r, row, a0[4 * g], a0[4 * g + 1], a0[4 * g + 2], a0[4 * g + 3]);
                store_vt4(vt, head, 32 + r, row, a1[4 * g], a1[4 * g + 1], a1[4 * g + 2], a1[4 * g + 3]);
            }
        } else if (grp < 32 || grp >= 44) {
            bf16_t* gate = (bf16_t*)(ws + OFF_GATE);
            const int cb = grp < 32 ? (grp - 24) * 64 : 512 + (grp - 44) * 64;
#pragma unroll
            for (int i = 0; i < 16; ++i) {
                const int row = row0 + crow(i, h);
                gate[(unsigned)row * 1024u + cb + r] = f2bf(silu(a0[i]));
                gate[(unsigned)row * 1024u + cb + 32 + r] = f2bf(silu(a1[i]));
            }
        } else if (grp < 37) {
            const int hh = r >> 4, i16 = r & 15;
            bf16_t* dst; int ld, cb;
            if (grp < 36) { dst = (bf16_t*)(ws + OFF_IQ); ld = 256; cb = (2 * (grp - 32) + hh) * 32; }
            else { dst = (bf16_t*)(ws + (hh ? OFF_KPE : OFF_IK)); ld = 32; cb = 0; }
#pragma unroll
            for (int i = 0; i < 16; ++i) {
                const int row = row0 + crow(i, h);
                const float2 cs = mi ? pcs[1][i] : pcs[0][i];
                const float x1 = a0[i], x2 = a1[i];
                dst[(unsigned)row * (unsigned)ld + cb + i16] = f2bf(x1 * cs.x - x2 * cs.y);
                dst[(unsigned)row * (unsigned)ld + cb + 16 + i16] = f2bf(x1 * cs.y + x2 * cs.x);
            }
        } else if (grp == 37) {
            float* iw = (float*)(ws + OFF_IW);
            if (r < 8) {
#pragma unroll
                for (int i = 0; i < 16; ++i) iw[(unsigned)(row0 + crow(i, h)) * 8u + r] = a0[i] * 0.0625f;
            }
        } else {
            bf16_t* dst; int ld, cb;
            if (grp < 42) { dst = (bf16_t*)(ws + OFF_CQ); ld = 256; cb = (grp - 38) * 64; }
            else { dst = (bf16_t*)(ws + OFF_CKV); ld = 128; cb = (grp - 42) * 64; }
#pragma unroll
            for (int i = 0; i < 16; ++i) {
                const int row = row0 + crow(i, h);
                dst[(unsigned)row * (unsigned)ld + cb + r] = f2bf(a0[i]);
                dst[(unsigned)row * (unsigned)ld + cb + 32 + r] = f2bf(a1[i]);
            }
        }
    }
};

struct EpiUq {
    char* ws; int head; const float* rs; int m0;
    DI void prefetch(int, int, int, int) {}
    DI void operator()(const f32x16& a0, const f32x16& a1, int row0, int wn, int r, int h, int) const {
        bf16_t* qb = (bf16_t*)(ws + OFF_QB);
        const float2* rope = (const float2*)(ws + OFF_ROPE);
        if (wn == 0) {
#pragma unroll
            for (int i = 0; i < 16; ++i) {
                const int row = row0 + crow(i, h); const float s = rs[row - m0];
                qb[(size_t)row * 768 + head * 96 + r] = f2bf(a0[i] * s);
                qb[(size_t)row * 768 + head * 96 + 32 + r] = f2bf(a1[i] * s);
            }
        } else if (r < 16) {
#pragma unroll
            for (int i = 0; i < 16; ++i) {
                const int row = row0 + crow(i, h); const float s = rs[row - m0];
                const float2 cs = rope[(size_t)row * 32 + 2 * r];
                const float x1 = a0[i] * s, x2 = a1[i] * s;
                qb[(size_t)row * 768 + head * 96 + 64 + r] = f2bf(x1 * cs.x - x2 * cs.y);
                qb[(size_t)row * 768 + head * 96 + 80 + r] = f2bf(x1 * cs.y + x2 * cs.x);
            }
        }
    }
};
struct EpiUkv {
    char* ws; int head; const float* rs; int m0;
    DI void prefetch(int, int, int, int) {}
    DI void operator()(const f32x16& a0, const f32x16& a1, int row0, int wn, int r, int h, int) const {
        if (wn == 0) {
            bf16_t* kb = (bf16_t*)(ws + OFF_KB);
#pragma unroll
            for (int i = 0; i < 16; ++i) {
                const int row = row0 + crow(i, h); const float s = rs[row - m0];
                kb[(size_t)row * 512 + head * 64 + r] = f2bf(a0[i] * s);
                kb[(size_t)row * 512 + head * 64 + 32 + r] = f2bf(a1[i] * s);
            }
        } else {
            bf16_t* vt = (bf16_t*)(ws + OFF_VTB);
#pragma unroll
            for (int g = 0; g < 4; ++g) {
                const int row = row0 + 8 * g + 4 * h;
                const float s0 = rs[row - m0], s1 = rs[row - m0 + 1], s2 = rs[row - m0 + 2], s3 = rs[row - m0 + 3];
                store_vt4(vt, head, r, row, a0[4 * g] * s0, a0[4 * g + 1] * s1, a0[4 * g + 2] * s2, a0[4 * g + 3] * s3);
                store_vt4(vt, head, 32 + r, row, a1[4 * g] * s0, a1[4 * g + 1] * s1, a1[4 * g + 2] * s2, a1[4 * g + 3] * s3);
            }
        }
    }
};
DI void row_rms(const bf16_t* A, int K, int m0, float* rs) {
    const int tid = threadIdx.x, row = tid >> 1, part = tid & 1, n = K >> 1;
    const bf16_t* p = A + (size_t)(m0 + row) * K + part * n;
    float s = 0.f;
    for (int j = 0; j < n; j += 8) {
        const u32x4 v = *(const u32x4*)(p + j);
#pragma unroll
        for (int q = 0; q < 4; ++q) { const float lo = __uint_as_float(v[q] << 16), hi = __uint_as_float(v[q] & 0xffff0000u); s += lo * lo + hi * hi; }
    }
    s += __shfl_xor(s, 1);
    __syncthreads();
    if (part == 0) rs[row] = __builtin_amdgcn_rsqf(s / (float)K + 1e-6f);
}

struct EpiOut {
    const float* x; float* out; int n0; float xv[2][2][16];
    DI void prefetch(int row0, int wn, int r, int h) {
#pragma unroll
        for (int mi = 0; mi < 2; ++mi)
#pragma unroll
            for (int i = 0; i < 16; ++i) {
                const size_t o = (size_t)(row0 + 32 * mi + crow(i, h)) * 1024 + n0 + 64 * wn + r;
                xv[mi][0][i] = x[o]; xv[mi][1][i] = x[o + 32];
            }
    }
    DI void operator()(const f32x16& a0, const f32x16& a1, int row0, int wn, int r, int h, int mi) {
#pragma unroll
        for (int i = 0; i < 16; ++i) {
            const size_t o = (size_t)(row0 + crow(i, h)) * 1024 + n0 + 64 * wn + r;
            out[o] = ALPHA * (mi ? xv[1][0][i] : xv[0][0][i]) + a0[i];
            out[o + 32] = ALPHA * (mi ? xv[1][1][i] : xv[0][1][i]) + a1[i];
        }
    }
};

typedef float f32x4 __attribute__((ext_vector_type(4)));
#define MFMA16(a, b, c) __builtin_amdgcn_mfma_f32_16x16x32_bf16((a), (b), (c), 0, 0, 0)
DI void indexer_stream(char* ws, char* lds, int G, int bid, int nrep) {
    constexpr int KMS = 2052;
    bf16_t* iqs = (bf16_t*)lds;
    unsigned* KM = (unsigned*)(lds + 16 * 264 * 2);
    const int tid = threadIdx.x, lane = tid & 63, w = __builtin_amdgcn_readfirstlane(tid >> 6), q = lane & 15, g = lane >> 4;
    const bf16_t* iq = (const bf16_t*)(ws + OFF_IQ);
    const bf16_t* ik = (const bf16_t*)(ws + OFF_IK);
    const float* iw = (const float*)(ws + OFF_IW);
    unsigned* maskw = (unsigned*)(ws + OFF_MASK);
    const int nrounds = (2048 + G - 1) / G, total = nrounds * nrep;
    auto unit_of = [&](int it, int& ub, int& uq) -> bool {
        if (it >= total) return false;
        const int rd = it % nrounds;
        const int u = (rd & 1) ? rd * G + (G - 1 - bid) : rd * G + bid;
        if (u >= 2048) return false;
        ub = u & 15; uq = 127 - (u >> 4);
        return true;
    };
    u32x4 iqrow; float wv[8]; bf16x8 af[16];
    auto load_inputs = [&](int ub, int uq) {
        const int tk0 = ub * SEQ + uq * 16;
        iqrow = *(const u32x4*)(iq + (size_t)(tk0 + (tid >> 5)) * 256 + (tid & 31) * 8);
        const float4 w0 = *(const float4*)(iw + (size_t)(tk0 + q) * 8), w1 = *(const float4*)(iw + (size_t)(tk0 + q) * 8 + 4);
        wv[0] = w0.x; wv[1] = w0.y; wv[2] = w0.z; wv[3] = w0.w; wv[4] = w1.x; wv[5] = w1.y; wv[6] = w1.z; wv[7] = w1.w;
#pragma unroll
        for (int jj = 0; jj < 16; ++jj) {
            const int kt = 2 * (w + 8 * (jj >> 1)) + (jj & 1);
            if (kt < uq + 1) af[jj] = *(const bf16x8*)(ik + (size_t)(ub * SEQ + kt * 16 + q) * 32 + 8 * g);
        }
    };
    int b = 0, qb16 = 0;
    bool have = unit_of(0, b, qb16);
    if (have) load_inputs(b, qb16);
  for (int it = 0; have; ++it) {
    const int ntiles = qb16 + 1;
    lds_barrier();
    *(u32x4*)(iqs + (tid >> 5) * 264 + (tid & 31) * 8) = iqrow;
    lds_barrier();
    bf16x8 bqr[8];
#pragma unroll
    for (int hd = 0; hd < 8; ++hd) bqr[hd] = *(const bf16x8*)(iqs + q * 264 + hd * 32 + 8 * g);
#pragma unroll
    for (int jj = 0; jj < 16; ++jj) {
        const int kt = 2 * (w + 8 * (jj >> 1)) + (jj & 1);
        if (kt < ntiles) {
            const int s0 = kt * 16;
            const int vlim = qb16 * 16 + q - s0 - 4 * g;
            const bf16x8 a = af[jj];
            f32x4 sc = {0.f, 0.f, 0.f, 0.f};
#pragma unroll
            for (int hd = 0; hd < 8; ++hd) {
                const bf16x8 bq = bqr[hd];
                f32x4 t = {0.f, 0.f, 0.f, 0.f};
                t = MFMA16(a, bq, t);
#pragma unroll
                for (int i = 0; i < 4; ++i) sc[i] = fmaf(wv[hd], fmaxf(t[i], 0.f), sc[i]);
            }
            u32x4 kv;
#pragma unroll
            for (int i = 0; i < 4; ++i) {
                const float xx = sc[i] + 0.0f;
                const unsigned u = __float_as_uint(xx);
                const unsigned k = u ^ ((unsigned)((int)u >> 31) | 0x80000000u);
                kv[i] = (i <= vlim) ? k : 0u;
            }
            *(u32x4*)(KM + q * KMS + s0 + 4 * g) = kv;
        }
    }
    int nb = 0, nq = 0;
    const bool hn = unit_of(it + 1, nb, nq);
    if (hn) load_inputs(nb, nq);
    lds_barrier();
    const int nk = ntiles * 16;
    unsigned KA[32], KB[32];
#pragma unroll
    for (int i = 0; i < 32; ++i) {
        const int idx = 64 * i + lane;
        KA[i] = 0u; KB[i] = 0u;
        if (64 * i < nk) {
            const bool in = idx < nk;
            const unsigned va = KM[(2 * w) * KMS + (in ? idx : 0)], vb = KM[(2 * w + 1) * KMS + (in ? idx : 0)];
            KA[i] = in ? va : 0u; KB[i] = in ? vb : 0u;
        }
    }
    unsigned TA = 0, TB = 0; int cgeA = 2048, cgeB = 2048;
    const int nvalA = qb16 * 16 + 2 * w + 1, nvalB = nvalA + 1;
    bool doneA = nvalA <= 256, doneB = nvalB <= 256;
    for (int bit = 31; bit >= 0; --bit) {
        if (doneA && doneB) break;
        const unsigned candA = TA | (1u << bit), candB = TB | (1u << bit);
        int a0 = 0, a1 = 0, a2 = 0, a3 = 0, b0 = 0, b1 = 0, b2 = 0, b3 = 0;
#pragma unroll
        for (int gq = 0; gq < 4; ++gq) {
            if (512 * gq < nk) {
#pragma unroll
                for (int i = 8 * gq; i < 8 * gq + 8; i += 4) {
                    CNT4(a0, a1, a2, a3, KA[i], KA[i + 1], KA[i + 2], KA[i + 3], candA);
                    CNT4(b0, b1, b2, b3, KB[i], KB[i + 1], KB[i + 2], KB[i + 3], candB);
                }
            }
        }
        const int cA = __builtin_amdgcn_readfirstlane(wave_sum_i((a0 + a1) + (a2 + a3)));
        const int cB = __builtin_amdgcn_readfirstlane(wave_sum_i((b0 + b1) + (b2 + b3)));
        if (!doneA && cA >= 256) { TA = candA; cgeA = cA; doneA = (cA == 256); }
        if (!doneB && cB >= 256) { TB = candB; cgeB = cB; doneB = (cB == 256); }
    }
    const int qb32 = qb16 >> 1;
#pragma unroll
    for (int qq = 0; qq < 2; ++qq) {
        const unsigned T = qq ? TB : TA;
        const int cge = qq ? cgeB : cgeA;
        const bool tie = (T != 0u) && (cge > 256);
        int need = 1 << 30;
        if (tie) {
            int cgt = 0;
#pragma unroll
            for (int i = 0; i < 32; ++i) cgt += __builtin_popcountll(__builtin_amdgcn_ballot_w64((qq ? KB[i] : KA[i]) > T));
            need = 256 - cgt;
        }
        unsigned long long* wscr = (unsigned long long*)(lds + 16 * 264 * 2 + 16 * KMS * 4) + (w * 2 + qq) * 32;
        if (!tie) {
            const unsigned Tm = T > 1u ? T : 1u;
#pragma unroll
            for (int i = 0; i < 32; ++i) {
                const unsigned long long sel = __builtin_amdgcn_ballot_w64((qq ? KB[i] : KA[i]) >= Tm);
                if (lane == 0) wscr[i] = sel;
            }
        } else
#pragma unroll
        for (int i = 0; i < 32; ++i) {
            const unsigned k = qq ? KB[i] : KA[i];
            const unsigned long long gt = __builtin_amdgcn_ballot_w64(k > T);
            unsigned long long eq = __builtin_amdgcn_ballot_w64(k == T && k != 0u);
            if (tie) {
                if (need <= 0) eq = 0ull;
                else {
                    const int ce = __builtin_popcountll(eq);
                    if (ce > need) {
                        unsigned long long mm = eq, keep = 0ull;
                        for (int n = need; n > 0; --n) { const unsigned long long lb = mm & (0ull - mm); keep |= lb; mm ^= lb; }
                        eq = keep;
                    }
                    need -= __builtin_popcountll(eq);
                }
            }
            const unsigned long long sel = gt | eq;
            if (lane == 0) wscr[i] = sel;
        }
        const unsigned myword = ((const unsigned*)wscr)[lane];
        const int r32 = (qb16 & 1) * 16 + 2 * w + qq;
        if (lane <= qb32) maskw[((size_t)(b * 64 + qb32) * 64 + lane) * 32 + r32] = myword;
    }
    b = nb; qb16 = nq; have = hn;
  }
}

constexpr int A_STAGE = 20480;
DI void glds4(const unsigned* g, char* l) { __builtin_amdgcn_global_load_lds(g, (unsigned*)l, 4, 0, 0); }
struct AUnit { const bf16_t* q; const bf16_t* k; const bf16_t* kpe; const bf16_t* vt; const unsigned* mwb; const bf16_t* gate; bf16_t* out; int c; };
constexpr int AQ_OFF = 4 * A_STAGE;
template <int DQK, bool MASKED>
DI void attn_block(const AUnit& U, int ldq, float cscale, char* lds, bool pre, bool has_next, const AUnit& N) {
    constexpr int NKS = DQK / 16, CH = DQK / 8, QW = 32 * DQK * 2, QP = QW / 1024;
    const int tid = threadIdx.x, lane = tid & 63, w = __builtin_amdgcn_readfirstlane(tid >> 6), r = lane & 31, h = lane >> 5;
    const int c = U.c, qb32 = 8 * c + w, t0 = qb32 * 32, ntile = 4 * c + 4;
    const bf16_t* gate = U.gate; bf16_t* outp = U.out;
    const int lr8 = lane >> 3, lp8 = lane & 7, row8 = 8 * w + lr8, c8 = lp8 ^ ((row8 >> 1) & 7);
    const int row4 = 16 * (w & 3) + (lane >> 2), c4 = (lane & 3) ^ ((row4 >> 2) & 3);
    auto issue_u = [&](const AUnit& X, int j, int st) {
        char* sb = lds + st * A_STAGE;
        glds16(X.k + (size_t)row8 * 512 + c8 * 8 + (size_t)j * 64 * 512, sb + w * 1024);
        glds16(X.vt + (size_t)row8 * 2048 + c8 * 8 + j * 64, sb + 8192 + w * 1024);
        if (DQK == 96) glds16(X.kpe + (size_t)row4 * 32 + c4 * 8 + (size_t)j * 64 * 32, sb + 16384 + (w & 3) * 1024);
        if (MASKED) glds4(X.mwb + (size_t)(8 * X.c + w) * 64 * 32 + lane + j * 64, sb + 16384 + w * 256);
    };
    auto issue = [&](int j, int st) { issue_u(U, j, st); };
    auto issue_q = [&](const AUnit& X) {
        const int tx0 = (8 * X.c + w) * 32;
#pragma unroll
        for (int pz = 0; pz < QP; ++pz) {
            const int ci = pz * 64 + lane, row = ci / CH, cc = ci % CH;
            glds16(X.q + (size_t)(tx0 + row) * ldq + cc * 8, lds + AQ_OFF + w * QW + pz * 1024);
        }
    };
    bf16x8 qf[NKS];
    u32x2 gpre[2][4];
    f32x16 o0, o1;
#pragma unroll
    for (int i = 0; i < 16; ++i) { o0[i] = 0.f; o1[i] = 0.f; }
    float m = -30000.0f, l = 0.f;
    f32x16 o2;
#pragma unroll
    for (int i = 0; i < 16; ++i) o2[i] = 0.f;
    const bf16x8 ones = {16256, 16256, 16256, 16256, 16256, 16256, 16256, 16256};
    const int dlc = r - 4 * h;
    const unsigned cmask = dlc < 0 ? 0u : (dlc >= 31 ? 0xffffffffu : ((2u << dlc) - 1u));
    if (!pre) { RAW_BARRIER(); issue_q(U); issue(0, 0); issue(1, 1); }
    for (int jp = 0; jp < ntile; jp += 2) {
        asm volatile("s_waitcnt vmcnt(0)" ::: "memory");
        RAW_BARRIER();
        if (jp + 2 < ntile) { issue(jp + 2, (jp + 2) & 3); issue(jp + 3, (jp + 3) & 3); }
        else if (has_next) { issue_u(N, 0, 0); issue_u(N, 1, 1); issue_q(N); }
        if (jp == 0) {
#pragma unroll
            for (int ks = 0; ks < NKS; ++ks) qf[ks] = *(const bf16x8*)(lds + AQ_OFF + w * QW + ((r * CH + 2 * ks + h) << 4));
            const bf16_t* gp = gate + (size_t)(t0 + r) * 1024;
#pragma unroll
            for (int db = 0; db < 2; ++db)
#pragma unroll
                for (int g = 0; g < 4; ++g) gpre[db][g] = *(const u32x2*)(gp + 32 * db + 8 * g + 4 * h);
        }
#pragma unroll 1
      for (int j = jp; j < jp + 2; ++j) {
        const char* sb = lds + (j & 3) * A_STAGE;
        if (2 * j <= qb32) {
            f32x16 s0, s1;
#pragma unroll
            for (int i = 0; i < 16; ++i) { s0[i] = 0.f; s1[i] = 0.f; }
            const int kr0 = r, kr1 = 32 + r;
#pragma unroll
            for (int ks = 0; ks < NKS; ++ks) {
                bf16x8 kf0, kf1;
                if (ks < 4) {
                    kf0 = *(const bf16x8*)(sb + kr0 * 128 + (((2 * ks + h) ^ ((kr0 >> 1) & 7)) << 4));
                    kf1 = *(const bf16x8*)(sb + kr1 * 128 + (((2 * ks + h) ^ ((kr1 >> 1) & 7)) << 4));
                } else {
                    kf0 = *(const bf16x8*)(sb + 16384 + kr0 * 64 + (((2 * (ks - 4) + h) ^ ((kr0 >> 2) & 3)) << 4));
                    kf1 = *(const bf16x8*)(sb + 16384 + kr1 * 64 + (((2 * (ks - 4) + h) ^ ((kr1 >> 2) & 3)) << 4));
                }
                s0 = MFMA32(kf0, qf[ks], s0);
                s1 = MFMA32(kf1, qf[ks], s1);
            }
            float mx = -30000.0f;
            const bool need_mask = MASKED || (2 * j + 1 >= qb32);
            if (need_mask) {
                unsigned mb0 = 0xffffffffu, mb1 = (2 * j + 1 <= qb32) ? 0xffffffffu : 0u;
                if (MASKED) {
                    mb0 = *(const unsigned*)(sb + 16384 + w * 256 + r * 4) >> (4 * h);
                    const unsigned w1 = *(const unsigned*)(sb + 16384 + w * 256 + (32 + r) * 4) >> (4 * h);
                    mb1 = (2 * j + 1 <= qb32) ? w1 : 0u;
                }
                if (2 * j == qb32) mb0 &= cmask;
                if (2 * j + 1 == qb32) mb1 &= cmask;
#pragma unroll
                for (int i = 0; i < 16; ++i) {
                    const int ci = (i & 3) + 8 * (i >> 2);
                    const unsigned t0m = (unsigned)(((int)(mb0 << (31 - ci))) >> 31), t1m = (unsigned)(((int)(mb1 << (31 - ci))) >> 31);
                    s0[i] = __uint_as_float((t0m & __float_as_uint(s0[i])) | (~t0m & 0xc6ea6000u));
                    s1[i] = __uint_as_float((t1m & __float_as_uint(s1[i])) | (~t1m & 0xc6ea6000u));
                }
            }
            {
                float mxa = mx, mxb = mx;
#pragma unroll
                for (int i = 0; i < 16; i += 2) {
                    asm("v_max3_f32 %0, %1, %2, %3" : "=v"(mxa) : "v"(mxa), "v"(s0[i]), "v"(s1[i]));
                    asm("v_max3_f32 %0, %1, %2, %3" : "=v"(mxb) : "v"(mxb), "v"(s0[i + 1]), "v"(s1[i + 1]));
                }
                asm("v_max_f32 %0, %1, %2" : "=v"(mx) : "v"(mxa), "v"(mxb));
            }
            mx = xor32_max(mx);
            const float mnw = fmaxf(m, mx);
            const float al = __builtin_amdgcn_exp2f((m - mnw) * cscale);
            const float nmc = -mnw * cscale;
#pragma unroll
            for (int i = 0; i < 16; ++i) {
                s0[i] = __builtin_amdgcn_exp2f(fmaf(s0[i], cscale, nmc)); s1[i] = __builtin_amdgcn_exp2f(fmaf(s1[i], cscale, nmc));
            }
            if (__builtin_amdgcn_ballot_w64(mnw > m) != 0) {
#pragma unroll
                for (int i = 0; i < 16; ++i) { o0[i] *= al; o1[i] *= al; }
                o2[0] *= al;
            }
            m = mnw;
            u32x4 pk[4];
#pragma unroll
            for (int q = 0; q < 4; ++q) {
                pk[0][q] = cvt_pk_bf16(s0[2 * q], s0[2 * q + 1]); pk[1][q] = cvt_pk_bf16(s0[8 + 2 * q], s0[8 + 2 * q + 1]);
                pk[2][q] = cvt_pk_bf16(s1[2 * q], s1[2 * q + 1]); pk[3][q] = cvt_pk_bf16(s1[8 + 2 * q], s1[8 + 2 * q + 1]);
            }
#pragma unroll
            for (int kk = 0; kk < 4; ++kk) {
                const bf16x8 pb = __builtin_bit_cast(bf16x8, pk[kk]);
                bf16x8 vfr[1][2];
#pragma unroll
                for (int db = 0; db < 2; ++db) { const int d = 32 * db + r; vfr[0][db] = *(const bf16x8*)(sb + 8192 + d * 128 + (((2 * kk + h) ^ ((d >> 1) & 7)) << 4)); }
                o0 = MFMA32(vfr[0][0], pb, o0);
                o1 = MFMA32(vfr[0][1], pb, o1);
                o2 = MFMA32(ones, pb, o2);
            }
        }
      }
    }
    l = o2[0];
    const float inv = 1.f / l;
    bf16_t* op = outp + (size_t)(t0 + r) * 1024;
#pragma unroll
    for (int db = 0; db < 2; ++db) {
#pragma unroll
        for (int g = 0; g < 4; ++g) {
            const int d = 32 * db + 8 * g + 4 * h;
            const u32x2 gv = gpre[db][g];
            float v0, v1, v2, v3;
            if (db == 0) { v0 = o0[4 * g]; v1 = o0[4 * g + 1]; v2 = o0[4 * g + 2]; v3 = o0[4 * g + 3]; }
            else { v0 = o1[4 * g]; v1 = o1[4 * g + 1]; v2 = o1[4 * g + 2]; v3 = o1[4 * g + 3]; }
            v0 *= inv * __uint_as_float(gv[0] << 16); v1 *= inv * __uint_as_float(gv[0] & 0xffff0000u);
            v2 *= inv * __uint_as_float(gv[1] << 16); v3 *= inv * __uint_as_float(gv[1] & 0xffff0000u);
            u32x2 ov; ov[0] = cvt_pk_bf16(v0, v1); ov[1] = cvt_pk_bf16(v2, v3);
            *(u32x2*)(op + d) = ov;
        }
    }
}

__global__ void __launch_bounds__(512) mega(Params p) {
    cg::grid_group grid = cg::this_grid();
    extern __shared__ __attribute__((aligned(16))) char lds[];
    char* ws = p.ws;
    const int tid = threadIdx.x, G = gridDim.x, bid = blockIdx.x;

#ifndef SKIP_P0
    for (int rep = 0; rep < REP0; ++rep) {
        if (bid == 0 && tid == 0) __hip_atomic_store((unsigned*)(ws + OFF_BAR), 0u, __ATOMIC_RELAXED, __HIP_MEMORY_SCOPE_AGENT);
        float* tile = (float*)lds;
        auto do_transposes = [&]() {
            transpose_convert(p.w_in, DIN, 1024, NPAD, (bf16_t*)(ws + OFF_WINT), nullptr, MapIn{}, tile);
            transpose_convert(p.w_uq, 768, 256, 1024, (bf16_t*)(ws + OFF_WUQT), p.qg, MapUq{}, tile);
            transpose_convert(p.w_ukv, 1024, 128, 1024, (bf16_t*)(ws + OFF_WUKVT), p.kvg, MapId{}, tile);
            transpose_convert(p.w_out, 1024, 1024, 1024, (bf16_t*)(ws + OFF_WOUTT), nullptr, MapId{}, tile);
        };
        auto do_xconv = [&]() {
            const size_t n4 = (size_t)NTOK * DM / 4;
            u32x2* xb = (u32x2*)(ws + OFF_XB);
            const size_t stride = (size_t)G * 512;
            for (size_t i0 = (size_t)bid * 512 + tid; i0 < n4; i0 += stride * 16) {
                float4 v[16];
#pragma unroll
                for (int u = 0; u < 16; ++u) { const size_t i = i0 + u * stride; if (i < n4) v[u] = nt_load4(p.x + 4 * i); }
#pragma unroll
                for (int u = 0; u < 16; ++u) {
                    const size_t i = i0 + u * stride;
                    if (i < n4) { u32x2 o; o[0] = cvt_pk_bf16(v[u].x, v[u].y); o[1] = cvt_pk_bf16(v[u].z, v[u].w); xb[i] = o; }
                }
            }
        };
        auto do_rope = [&]() {
            float2* rope = (float2*)(ws + OFF_ROPE);
            for (int i = bid * 512 + tid; i < NTOK * 32; i += G * 512) {
                const int tok = i >> 5, f = i & 31;
                const float inv = powf(10000.0f, -(float)f / 32.0f);
                const float ang = (float)p.pos[tok] * inv;
                float sn, cs; sincosf(ang, &sn, &cs);
                rope[i] = make_float2(cs, sn);
            }
        };
        if ((bid >> 3) & 1) { do_xconv(); do_rope(); do_transposes(); }
        else { do_transposes(); do_xconv(); do_rope(); }
    }
#endif
    grid.sync();

    float* rs_s = (float*)(lds + 3 * G_STAGE);
    const int xcd = bid & 7, li = bid >> 3, nxb = G >> 3;
#ifndef SKIP_P1
    for (int rep = 0; rep < REP1; ++rep) {
        for (int t = li; t < 192; t += nxb) {
            const int mg = t / 52, rem = t % 52, nt4 = rem >> 2, mi = rem & 3;
            const int mt = xcd * 16 + mg * 4 + mi;
            EpiIn e; e.ws = ws; e.nt = 0;
            gemm256x256((const bf16_t*)(ws + OFF_XB), 1024, (const bf16_t*)(ws + OFF_WINT), 1024, 1024, mt * 256, nt4 * 256, lds, e);
        }
        if (li < 32) {
            const int t = 192 + (li >> 1), mg = t / 52, rem = t % 52, nt4 = rem >> 2, mi = rem & 3;
            const int mt = xcd * 16 + mg * 4 + mi, nt2 = nt4 * 2 + (li & 1);
            EpiIn e; e.ws = ws; e.nt = nt2;
            gemm256((const bf16_t*)(ws + OFF_XB), 1024, (const bf16_t*)(ws + OFF_WINT), 1024, 1024, mt * 256, nt2 * 128, lds, e);
        }
    }
#endif
    fast_grid_barrier((unsigned*)(ws + OFF_BAR), 1u * (unsigned)G);

    auto do_p2 = [&]() {
    for (int rep = 0; rep < REP2; ++rep)
    for (int t = bid; t < 256; t += G) {
        const int kind = t >> 7, mt = t & 127;
        if (kind == 0) {
            row_rms((const bf16_t*)(ws + OFF_CQ), 256, mt * 256, rs_s);
            for (int nt2 = 0; nt2 < 8; ++nt2) {
                EpiUq e{ws, nt2, rs_s, mt * 256};
                gemm256((const bf16_t*)(ws + OFF_CQ), 256, (const bf16_t*)(ws + OFF_WUQT), 256, 256, mt * 256, nt2 * 128, lds, e);
            }
        } else {
            row_rms((const bf16_t*)(ws + OFF_CKV), 128, mt * 256, rs_s);
            for (int nt2 = 0; nt2 < 8; ++nt2) {
                EpiUkv e{ws, nt2, rs_s, mt * 256};
                gemm256((const bf16_t*)(ws + OFF_CKV), 128, (const bf16_t*)(ws + OFF_WUKVT), 128, 128, mt * 256, nt2 * 128, lds, e);
            }
        }
    }
    };
    if ((bid >> 3) & 1) { indexer_stream(ws, lds, G, bid, REP3); do_p2(); }
    else { do_p2(); indexer_stream(ws, lds, G, bid, REP3); }
    fast_grid_barrier((unsigned*)(ws + OFF_BAR), 2u * (unsigned)G);

#ifndef SKIP_P4
    for (int rep = 0; rep < REP4; ++rep) {
        auto unit_of = [&](int rd, int& branch, AUnit& U) -> bool {
            int c, rest;
            if (G == 256) { if (rd >= 8) return false; rest = xcd * 32 + rd * 4 + (li >> 3); c = ((li & 7) + rd) & 7; }
            else { const int u = rd * G + bid; if (u >= 2048) return false; c = 7 - (u >> 8); rest = u & 255; }
            branch = rest >> 7;
            const int b = (rest >> 3) & 15, head = rest & 7;
            const size_t tokb = (size_t)b * SEQ;
            U.c = c;
            if (branch == 0) {
                U.q = (const bf16_t*)(ws + OFF_QA) + tokb * 512 + head * 64; U.k = (const bf16_t*)(ws + OFF_KA) + tokb * 512 + head * 64; U.kpe = nullptr;
                U.vt = (const bf16_t*)(ws + OFF_VTA) + (size_t)(b * 8 + head) * 64 * 2048; U.mwb = (const unsigned*)(ws + OFF_MASK) + (size_t)(b * 64) * 64 * 32;
                U.gate = (const bf16_t*)(ws + OFF_GATE) + tokb * 1024 + head * 64; U.out = (bf16_t*)(ws + OFF_XB) + tokb * 1024 + head * 64;
            } else {
                U.q = (const bf16_t*)(ws + OFF_QB) + tokb * 768 + head * 96; U.k = (const bf16_t*)(ws + OFF_KB) + tokb * 512 + head * 64; U.kpe = (const bf16_t*)(ws + OFF_KPE) + tokb * 32;
                U.vt = (const bf16_t*)(ws + OFF_VTB) + (size_t)(b * 8 + head) * 64 * 2048; U.mwb = nullptr;
                U.gate = (const bf16_t*)(ws + OFF_GATE) + tokb * 1024 + 512 + head * 64; U.out = (bf16_t*)(ws + OFF_XB) + tokb * 1024 + 512 + head * 64;
            }
            return true;
        };
        AUnit U, N; int br = 0, brn = 0, rd = 0;
        while (unit_of(rd, br, U)) {
            bool pre = false;
            if (br == 0) {
                for (;;) {
                    const bool chain = unit_of(rd + 1, brn, N) && brn == 0;
                    attn_block<64, true>(U, 512, 0.125f * 1.44269504089f, lds, pre, chain, N);
                    ++rd; if (!chain) break; pre = true; U = N;
                }
            } else {
                for (;;) {
                    const bool chain = unit_of(rd + 1, brn, N) && brn == 1;
                    attn_block<96, false>(U, 768, 0.10206207262f * 1.44269504089f, lds, pre, chain, N);
                    ++rd; if (!chain) break; pre = true; U = N;
                }
            }
        }
    }
#endif
    fast_grid_barrier((unsigned*)(ws + OFF_BAR), 3u * (unsigned)G);

#ifndef SKIP_P5
    for (int rep = 0; rep < REP5; ++rep)
    for (int t = li; t < 128; t += nxb) {
        const int mg = t >> 5, rem = t & 31, nt2 = rem >> 2, mi = rem & 3;
        const int mt = xcd * 16 + mg * 4 + mi;
        EpiOut e; e.x = p.x; e.out = p.out; e.n0 = nt2 * 128;
        gemm256((const bf16_t*)(ws + OFF_XB), 1024, (const bf16_t*)(ws + OFF_WOUTT), 1024, 1024, mt * 256, nt2 * 128, lds, e);
    }
#endif
    fast_grid_barrier((unsigned*)(ws + OFF_BAR), 4u * (unsigned)G);

    {
        const int lane = tid & 63, w = __builtin_amdgcn_readfirstlane(tid >> 6);
        const int NWv = G * 8, gw = bid * 8 + w;
        float4 gg[4], bb[4];
#pragma unroll
        for (int i = 0; i < 4; ++i) { gg[i] = ((const float4*)p.ln_g)[lane + 64 * i]; bb[i] = ((const float4*)p.ln_b)[lane + 64 * i]; }
        for (int row0 = gw * 4; row0 < NTOK; row0 += NWv * 4) {
            float4 v[4][4];
#pragma unroll
            for (int rr = 0; rr < 4; ++rr)
#pragma unroll
                for (int i = 0; i < 4; ++i) v[rr][i] = nt_load4(p.out + (size_t)(row0 + rr) * 1024 + 4 * (lane + 64 * i));
            float s[4], q[4];
#pragma unroll
            for (int rr = 0; rr < 4; ++rr) {
                s[rr] = 0.f;
#pragma unroll
                for (int i = 0; i < 4; ++i) s[rr] += v[rr][i].x + v[rr][i].y + v[rr][i].z + v[rr][i].w;
            }
#pragma unroll
            for (int off = 32; off >= 1; off >>= 1)
#pragma unroll
                for (int rr = 0; rr < 4; ++rr) s[rr] += __shfl_xor(s[rr], off);
#pragma unroll
            for (int rr = 0; rr < 4; ++rr) {
                const float mu = s[rr] * (1.f / 1024.f);
                q[rr] = 0.f;
#pragma unroll
                for (int i = 0; i < 4; ++i) {
                    v[rr][i].x -= mu; v[rr][i].y -= mu; v[rr][i].z -= mu; v[rr][i].w -= mu;
                    q[rr] += v[rr][i].x * v[rr][i].x + v[rr][i].y * v[rr][i].y + v[rr][i].z * v[rr][i].z + v[rr][i].w * v[rr][i].w;
                }
            }
#pragma unroll
            for (int off = 32; off >= 1; off >>= 1)
#pragma unroll
                for (int rr = 0; rr < 4; ++rr) q[rr] += __shfl_xor(q[rr], off);
#pragma unroll
            for (int rr = 0; rr < 4; ++rr) {
                const float rstd = __builtin_amdgcn_rsqf(q[rr] * (1.f / 1024.f) + 1e-5f);
#pragma unroll
                for (int i = 0; i < 4; ++i) {
                    float4 y; y.x = v[rr][i].x * rstd * gg[i].x + bb[i].x; y.y = v[rr][i].y * rstd * gg[i].y + bb[i].y;
                    y.z = v[rr][i].z * rstd * gg[i].z + bb[i].z; y.w = v[rr][i].w * rstd * gg[i].w + bb[i].w;
                    nt_store4(p.out + (size_t)(row0 + rr) * 1024 + 4 * (lane + 64 * i), y);
                }
            }
        }
    }
}

extern "C" void kernel_launch(void* const* d_in, const int* in_sizes, int n_in, void* d_out, int out_size, void* d_ws, size_t ws_size, hipStream_t stream) {
    static int grid_blocks = 0;
    if (!grid_blocks) {
        int dev = 0, cus = 0, per_cu = 0;
        hipGetDevice(&dev);
        hipDeviceGetAttribute(&cus, hipDeviceAttributeMultiprocessorCount, dev);
        if (hipFuncSetAttribute((const void*)mega, hipFuncAttributeMaxDynamicSharedMemorySize, LDS_BYTES) != hipSuccess) fprintf(stderr, "kernel_launch: hipFuncSetAttribute failed\n");
        if (hipOccupancyMaxActiveBlocksPerMultiprocessor(&per_cu, mega, 512, LDS_BYTES) != hipSuccess || per_cu < 1) per_cu = 1;
        if (per_cu > 1) per_cu = 1;
        grid_blocks = cus * per_cu;
        if (ws_size < WS_END) fprintf(stderr, "kernel_launch: workspace too small: %zu < %zu\n", ws_size, (size_t)WS_END);
    }
    Params p{};
    p.x = (const float*)d_in[0]; p.pos = (const int*)d_in[1]; p.w_in = (const float*)d_in[2]; p.qg = (const float*)d_in[3];
    p.w_uq = (const float*)d_in[4]; p.kvg = (const float*)d_in[5]; p.w_ukv = (const float*)d_in[6]; p.w_out = (const float*)d_in[7];
    p.ln_g = (const float*)d_in[8]; p.ln_b = (const float*)d_in[9]; p.out = (float*)d_out; p.ws = (char*)d_ws;
    void* args[] = {&p};
    hipError_t e = hipLaunchCooperativeKernel((const void*)mega, dim3(grid_blocks), dim3(512), args, LDS_BYTES, stream);
    if (e != hipSuccess) fprintf(stderr, "cooperative launch failed: %s (grid %d)\n", hipGetErrorString(e), grid_blocks);
}
```
